# Optimizing an MI355X kernel written in HIP

```python
import jax, jax.numpy as jnp
from jax import lax
import numpy as np

D_MODEL = 2048
BATCH = 2
SEQ = 8192
DEPTH = 1

CHUNK = 64
Q_BLOCK = 128
EPS = 1e-6
D_FF = 5632

GLA_HEADS = 4
GLA_KEY = D_MODEL // 2
GLA_VAL = D_MODEL
GLA_DK = GLA_KEY // GLA_HEADS
GLA_DV = GLA_VAL // GLA_HEADS
GLA_GATE_RANK = 16
GLA_GATE_NORMALIZER = 16.0

FOX_DH = 128
FOX_HEADS = D_MODEL // FOX_DH
FOX_W = FOX_HEADS * FOX_DH

IN_SIZES = (GLA_KEY, GLA_KEY, GLA_VAL, GLA_VAL, GLA_GATE_RANK,
            FOX_W, FOX_W, FOX_W, FOX_HEADS, FOX_W, D_MODEL, D_MODEL)
IN_WIDTH = sum(IN_SIZES)

kernel_name = "hybrid_gla_fox_macaron_block"


def rmsnorm(x, g):
    x32 = x.astype(jnp.float32)
    r = x32 * lax.rsqrt(jnp.mean(x32 * x32, axis=-1, keepdims=True) + EPS)
    return (r * g.astype(jnp.float32)).astype(x.dtype)


def swiglu(x, w_in, w_out):
    gu = x @ w_in
    g, u = gu[..., :D_FF], gu[..., D_FF:]
    return (jax.nn.silu(g) * u) @ w_out


def split_columns(p):
    parts, off = [], 0
    for n in IN_SIZES:
        parts.append(p[..., off:off + n])
        off += n
    return parts


def gla_branch(q, k, v, r, a_lr, w_a_up, b_a, g_onorm):
    B, T, _ = q.shape
    nc = T // CHUNK
    q = q.reshape(B, nc, CHUNK, GLA_HEADS, GLA_DK) * (GLA_DK ** -0.5)
    k = k.reshape(B, nc, CHUNK, GLA_HEADS, GLA_DK)
    v = v.reshape(B, nc, CHUNK, GLA_HEADS, GLA_DV)
    log_a = jax.nn.log_sigmoid((a_lr @ w_a_up + b_a).astype(jnp.float32)) / GLA_GATE_NORMALIZER
    G = jnp.cumsum(log_a.reshape(B, nc, CHUNK, GLA_HEADS, GLA_DK), axis=2)
    G_end = G[:, :, -1]
    k_dec = (k * jnp.exp(G_end[:, :, None] - G)).astype(k.dtype)
    a_chunk = jnp.exp(G_end).astype(k.dtype)

    def step(S, inp):
        q_c, k_c, v_c, a_c = inp
        S = a_c[..., None] * S + jnp.einsum("bchk,bchv->bhkv", k_c, v_c)
        o_c = jnp.einsum("bchk,bhkv->bchv", q_c, S)
        return S, o_c

    xs = (jnp.moveaxis(q, 1, 0), jnp.moveaxis(k_dec, 1, 0),
          jnp.moveaxis(v, 1, 0), jnp.moveaxis(a_chunk, 1, 0))
    S0 = jnp.zeros((B, GLA_HEADS, GLA_DK, GLA_DV), jnp.float32)
    _, o = lax.scan(step, S0, xs)
    o = jnp.moveaxis(o, 0, 1).reshape(B, T, GLA_HEADS, GLA_DV).astype(v.dtype)
    o = rmsnorm(o, g_onorm)
    return o.reshape(B, T, GLA_VAL) * jax.nn.silu(r)


def fox_branch(q, k, v, f_logit, og, b_f, g_q, g_k):
    B, T, _ = q.shape
    q = rmsnorm(q.reshape(B, T, FOX_HEADS, FOX_DH), g_q) * (FOX_DH ** -0.5)
    k = rmsnorm(k.reshape(B, T, FOX_HEADS, FOX_DH), g_k)
    v = v.reshape(B, T, FOX_HEADS, FOX_DH)
    log_f = jax.nn.log_sigmoid(f_logit.astype(jnp.float32) + b_f.astype(jnp.float32))
    F = jnp.transpose(jnp.cumsum(log_f, axis=1), (0, 2, 1))
    outs = []
    for i in range(T // Q_BLOCK):
        q0, q1 = i * Q_BLOCK, (i + 1) * Q_BLOCK
        s = jnp.einsum("bqhd,bkhd->bhqk", q[:, q0:q1], k[:, :q1]).astype(jnp.float32)
        s = s + F[:, :, q0:q1, None] - F[:, :, None, :q1]
        q_idx = q0 + jnp.arange(Q_BLOCK)
        k_idx = jnp.arange(q1)
        s = jnp.where(k_idx[None, :] <= q_idx[:, None], s, -jnp.inf)
        p = jax.nn.softmax(s, axis=-1).astype(v.dtype)
        outs.append(jnp.einsum("bhqk,bkhd->bqhd", p, v[:, :q1]))
    o = jnp.concatenate(outs, axis=1).reshape(B, T, FOX_W)
    return o * jax.nn.sigmoid(og)


def mixer(h, w_in, gla_w_a_up, gla_b_a, gla_onorm, fox_b_f, fox_q_norm, fox_k_norm,
          w_br_gla, w_br_fox, b_merge, w_out):
    (g_q, g_k, g_v, g_r, g_alr, f_q, f_k, f_v, f_f, f_og, m_gla, m_fox) = split_columns(h @ w_in)
    y_gla = gla_branch(g_q, g_k, g_v, g_r, g_alr, gla_w_a_up, gla_b_a, gla_onorm) @ w_br_gla
    y_fox = fox_branch(f_q, f_k, f_v, f_f, f_og, fox_b_f, fox_q_norm, fox_k_norm) @ w_br_fox
    merged = jax.nn.sigmoid(m_gla + b_merge[0]) * y_gla + jax.nn.sigmoid(m_fox + b_merge[1]) * y_fox
    return merged @ w_out


def setup_inputs(seed: int = 0) -> dict:
    key = jax.random.key(seed)
    ks = jax.random.split(key, 24)

    def w(k, shape, fan_in):
        return jax.random.normal(k, shape, jnp.float32) * (fan_in ** -0.5)

    def gain(k, shape):
        return 1.0 + 0.02 * jax.random.normal(k, shape, jnp.float32)

    def small(k, shape):
        return 0.01 * jax.random.normal(k, shape, jnp.float32)

    L = DEPTH
    return {
        "x": jax.random.normal(ks[0], (BATCH, SEQ, D_MODEL), jnp.float32),
        "norm_ffn1": gain(ks[1], (L, D_MODEL)),
        "ffn1_w_in": w(ks[2], (L, D_MODEL, 2 * D_FF), D_MODEL),
        "ffn1_w_out": w(ks[3], (L, D_FF, D_MODEL), D_FF),
        "norm_mix": gain(ks[4], (L, D_MODEL)),
        "w_in": w(ks[5], (L, D_MODEL, IN_WIDTH), D_MODEL),
        "gla_w_a_up": w(ks[6], (L, GLA_GATE_RANK, GLA_KEY), GLA_GATE_RANK),
        "gla_b_a": small(ks[7], (L, GLA_KEY)),
        "gla_onorm": gain(ks[8], (L, GLA_HEADS, GLA_DV)),
        "fox_b_f": jax.random.uniform(ks[9], (L, FOX_HEADS), jnp.float32, 0.0, 4.0),
        "fox_q_norm": gain(ks[10], (L, FOX_DH)),
        "fox_k_norm": gain(ks[11], (L, FOX_DH)),
        "w_br_gla": w(ks[12], (L, GLA_VAL, D_MODEL), GLA_VAL),
        "w_br_fox": w(ks[13], (L, FOX_W, D_MODEL), FOX_W),
        "b_merge": small(ks[14], (L, 2, D_MODEL)),
        "w_out": w(ks[15], (L, D_MODEL, D_MODEL), D_MODEL),
        "norm_ffn2": gain(ks[16], (L, D_MODEL)),
        "ffn2_w_in": w(ks[17], (L, D_MODEL, 2 * D_FF), D_MODEL),
        "ffn2_w_out": w(ks[18], (L, D_FF, D_MODEL), D_FF),
        "norm_final": gain(ks[19], (D_MODEL,)),
    }


def reference(x, norm_ffn1, ffn1_w_in, ffn1_w_out, norm_mix, w_in, gla_w_a_up, gla_b_a,
              gla_onorm, fox_b_f, fox_q_norm, fox_k_norm, w_br_gla, w_br_fox, b_merge,
              w_out, norm_ffn2, ffn2_w_in, ffn2_w_out, norm_final):
    for l in range(DEPTH):
        x = x + 0.5 * swiglu(rmsnorm(x, norm_ffn1[l]), ffn1_w_in[l], ffn1_w_out[l])
        x = x + mixer(rmsnorm(x, norm_mix[l]), w_in[l], gla_w_a_up[l], gla_b_a[l], gla_onorm[l],
                      fox_b_f[l], fox_q_norm[l], fox_k_norm[l], w_br_gla[l], w_br_fox[l],
                      b_merge[l], w_out[l])
        x = x + 0.5 * swiglu(rmsnorm(x, norm_ffn2[l]), ffn2_w_in[l], ffn2_w_out[l])
    return rmsnorm(x, norm_final)
```

```cpp
#include <hip/hip_runtime.h>
#include <hip/hip_bf16.h>
#include <hip/hip_cooperative_groups.h>
#include <cstdio>
#include <cstdint>
#ifndef MK_MULTI
#define MK_MULTI 0
#endif
namespace cg = cooperative_groups;
namespace pg8 {
#define PG8_LAS __attribute__((address_space(3)))
typedef unsigned short bf16_t;
typedef short bf16x8 __attribute__((ext_vector_type(8)));
typedef float f32x4 __attribute__((ext_vector_type(4)));
typedef unsigned u32x4 __attribute__((ext_vector_type(4)));
constexpr int BM = 256, BK = 64, HALF = 128, HTB = HALF * BK * 2  , STAGE_BYTES = 8 * HTB, NXCD = 8, WGM = 8;

__host__ __device__ __forceinline__ int lds_byte(int r, int c) { const int st = (r >> 4) * 2 + (c >> 5), rr = r & 15, cc = c & 31, ob = rr * 64 + cc * 2; return st * 1024 + (ob ^ (((ob >> 9) & 1) << 5)); }
__host__ __device__ __forceinline__ void stage_rc(int b, int& R, int& C) { const int st = b / 1024, sb = b % 1024, swz = sb ^ (((sb >> 9) & 1) << 5); R = (st >> 1) * 16 + swz / 64; C = (st & 1) * 32 + (swz % 64) / 2; }
__host__ __device__ __forceinline__ int perm32(int rho) { const int n = rho >> 4, i = rho & 15; return 8 * (i >> 2) + 4 * n + (i & 3); }

struct Unit { int pm, pn; };
struct Gemm { const bf16_t* A; const bf16_t* Bt; int M, N, K; };

struct StaticOrder {
    int nM, nN, nwg, G, c, wgm;
    __host__ __device__ void init(int M, int N, int G_, int c_, int wgm_ = WGM) { nM = M / BM; nN = N / BM; nwg = nM * nN; G = G_; c = c_; wgm = wgm_; }
    __host__ __device__ bool next(int i, Unit& u) const {
        const long L = (long)i * G + c; if (L >= nwg) return false;
        int wgid = (int)L; { const int q = nwg / NXCD, r = nwg % NXCD, xcd = wgid % NXCD, off = wgid / NXCD; wgid = (xcd < r ? xcd * (q + 1) : r * (q + 1) + (xcd - r) * q) + off; }
        const int nig = wgm * nN, gid = wgid / nig, fm = gid * wgm, gsz = (nM - fm) < wgm ? (nM - fm) : wgm;
        u.pm = fm + ((wgid % nig) % gsz); u.pn = (wgid % nig) / gsz; return true;
    }
    __device__ __forceinline__ void a_ready(const Unit&) const {}
    __device__ __forceinline__ void done(const Unit&) const {}
};

typedef float f32x2c_t __attribute__((ext_vector_type(2))); typedef __bf16 bf16x2c_t __attribute__((ext_vector_type(2)));
__device__ __forceinline__ unsigned cvt_pk_bf16(float lo, float hi) { const f32x2c_t v = {lo, hi}; const bf16x2c_t b = __builtin_convertvector(v, bf16x2c_t); return __builtin_bit_cast(unsigned, b); }
typedef float f32x2 __attribute__((ext_vector_type(2)));
__device__ __forceinline__ f32x2 gelu_pk(f32x2 v) {
    const f32x2 av = __builtin_elementwise_abs(v), d = av * 0.2316418882f + 1.0f;
    f32x2 t; t.x = __builtin_amdgcn_rcpf(d.x); t.y = __builtin_amdgcn_rcpf(d.y);
    f32x2 q = t * 0.5307027145f + (-0.7265760135f); q = q * t + 0.7107068705f; q = q * t + (-0.142248368f); q = q * t + 0.127414796f; q = q * t;
    const f32x2 s = (v * v) * (-0.72134752044f);
    f32x2 e; e.x = __builtin_amdgcn_exp2f(s.x); e.y = __builtin_amdgcn_exp2f(s.y);
    const f32x2 m = v * (q * e), r = v - m;
    f32x2 o; o.x = v.x < 0.f ? m.x : r.x; o.y = v.y < 0.f ? m.y : r.y; return o;
}

template <int ACT  > struct EpiBf16 {
    static constexpr bool PERM = true, AFTER_DRAIN = false; static_assert(ACT == 0 || ACT == 1, "EpiBf16: ACT is 0 (none) or 1 (gelu_pk)");
    bf16_t* O; int ldc; const float* bias; int split_cols; size_t split_stride; float scale0;
    __device__ __forceinline__ void operator()(const f32x4 (&acc)[2][2][4][2], const Unit& u, int wr, int wc, int fr, int fq) const {
        const int row0 = u.pm * BM + wr * 64 + fr; int colt = u.pn * BM; bf16_t* base = O;
        float sc = 1.f; if (split_cols) { const int t = colt / split_cols; base += (size_t)t * split_stride; colt -= t * split_cols; if (t == 0) sc = scale0; }
        const int col0 = colt + wc * 32 + 8 * fq, bcol0 = u.pn * BM + wc * 32 + 8 * fq;
        f32x4 bv[2][2];
#pragma unroll
        for (int bj = 0; bj < 2; ++bj)
#pragma unroll
            for (int n = 0; n < 2; ++n) bv[bj][n] = bias ? *(const f32x4*)(bias + bcol0 + bj * HALF + 4 * n) : (f32x4){0.f, 0.f, 0.f, 0.f};
#pragma unroll
        for (int ai = 0; ai < 2; ++ai)
#pragma unroll
            for (int m = 0; m < 4; ++m) { bf16_t* rowp = base + (size_t)(row0 + ai * HALF + m * 16) * ldc + col0;
#pragma unroll
                for (int bj = 0; bj < 2; ++bj) { f32x4 v0 = acc[ai][bj][m][0] + bv[bj][0], v1 = acc[ai][bj][m][1] + bv[bj][1];
                    if (ACT == 1) { f32x2 a = gelu_pk((f32x2){v0[0], v0[1]}), b = gelu_pk((f32x2){v0[2], v0[3]}), c = gelu_pk((f32x2){v1[0], v1[1]}), d = gelu_pk((f32x2){v1[2], v1[3]});
                        v0 = (f32x4){a.x, a.y, b.x, b.y}; v1 = (f32x4){c.x, c.y, d.x, d.y}; }
                    v0 = v0 * sc; v1 = v1 * sc; u32x4 w; w.x = cvt_pk_bf16(v0[0], v0[1]); w.y = cvt_pk_bf16(v0[2], v0[3]); w.z = cvt_pk_bf16(v1[0], v1[1]); w.w = cvt_pk_bf16(v1[2], v1[3]);
                    *(u32x4*)(rowp + bj * HALF) = w; } }
    }
};
__device__ __forceinline__ float sigmoid_f(float x) { return __builtin_amdgcn_rcpf(1.0f + __builtin_amdgcn_exp2f(-1.4426950408889634f * x)); }
__device__ __forceinline__ float silu_f(float x) { return x * sigmoid_f(x); }
__device__ __forceinline__ float bf_lo(unsigned w) { return __uint_as_float(w << 16); }
__device__ __forceinline__ float bf_hi(unsigned w) { return __uint_as_float(w & 0xffff0000u); }
typedef unsigned u32x2 __attribute__((ext_vector_type(2)));

struct EpiSwiGLU {
    static constexpr bool PERM = true, AFTER_DRAIN = false;
    bf16_t* H; int ldh; const float* rs;
    __device__ __forceinline__ void operator()(const f32x4 (&acc)[2][2][4][2], const Unit& u, int wr, int wc, int fr, int fq) const {
        const int row0 = u.pm * BM + wr * 64 + fr, col0 = u.pn * HALF + wc * 32 + 8 * fq;
#pragma unroll
        for (int ai = 0; ai < 2; ++ai)
#pragma unroll
            for (int m = 0; m < 4; ++m) {
                bf16_t* rowp = H + (size_t)(row0 + ai * HALF + m * 16) * ldh + col0;
                const float rstd = rs ? __builtin_amdgcn_rsqf(rs[row0 + ai * HALF + m * 16] * (1.0f / 2048.0f) + 1e-6f) : 1.0f;
                const f32x4 g0 = acc[ai][0][m][0] * rstd, g1 = acc[ai][0][m][1] * rstd, u0 = acc[ai][1][m][0] * rstd, u1 = acc[ai][1][m][1] * rstd;
                u32x4 w;
                w.x = cvt_pk_bf16(silu_f(g0[0]) * u0[0], silu_f(g0[1]) * u0[1]); w.y = cvt_pk_bf16(silu_f(g0[2]) * u0[2], silu_f(g0[3]) * u0[3]);
                w.z = cvt_pk_bf16(silu_f(g1[0]) * u1[0], silu_f(g1[1]) * u1[1]); w.w = cvt_pk_bf16(silu_f(g1[2]) * u1[2], silu_f(g1[3]) * u1[3]);
                *(u32x4*)rowp = w;
            }
    }
};
template <bool BASE_BF, bool OUT_BF> struct EpiResid {
    static constexpr bool PERM = true, AFTER_DRAIN = false;
    const void* base; void* out; float scale; float* rs;
    __device__ __forceinline__ void operator()(const f32x4 (&acc)[2][2][4][2], const Unit& u, int wr, int wc, int fr, int fq) const {
        const int row0 = u.pm * BM + wr * 64 + fr, col0 = u.pn * BM + wc * 32 + 8 * fq;
#pragma unroll
        for (int ai = 0; ai < 2; ++ai) {
            f32x4 bv[4][2][2];
#pragma unroll
            for (int m = 0; m < 4; ++m)
#pragma unroll
                for (int bj = 0; bj < 2; ++bj) { const size_t off = (size_t)(row0 + ai * HALF + m * 16) * 2048 + col0 + bj * HALF;
                    if (BASE_BF) { const u32x4 w = *(const u32x4*)((const bf16_t*)base + off); bv[m][bj][0] = (f32x4){bf_lo(w.x), bf_hi(w.x), bf_lo(w.y), bf_hi(w.y)}; bv[m][bj][1] = (f32x4){bf_lo(w.z), bf_hi(w.z), bf_lo(w.w), bf_hi(w.w)}; }
                    else { const float* bp = (const float*)base + off; bv[m][bj][0] = *(const f32x4*)bp; bv[m][bj][1] = *(const f32x4*)(bp + 4); } }
            asm volatile("" ::: "memory");
#pragma unroll
            for (int m = 0; m < 4; ++m) { const int row = row0 + ai * HALF + m * 16; float ss = 0.f;
#pragma unroll
                for (int bj = 0; bj < 2; ++bj) { const size_t off = (size_t)row * 2048 + col0 + bj * HALF;
                    const f32x4 y0 = bv[m][bj][0] + acc[ai][bj][m][0] * scale, y1 = bv[m][bj][1] + acc[ai][bj][m][1] * scale;
                    ss += ((y0[0] * y0[0] + y0[1] * y0[1]) + (y0[2] * y0[2] + y0[3] * y0[3])) + ((y1[0] * y1[0] + y1[1] * y1[1]) + (y1[2] * y1[2] + y1[3] * y1[3]));
                    if (OUT_BF) { u32x4 w; w.x = cvt_pk_bf16(y0[0], y0[1]); w.y = cvt_pk_bf16(y0[2], y0[3]); w.z = cvt_pk_bf16(y1[0], y1[1]); w.w = cvt_pk_bf16(y1[2], y1[3]); *(u32x4*)((bf16_t*)out + off) = w; }
                    else { float* op = (float*)out + off; *(f32x4*)op = y0; *(f32x4*)(op + 4) = y1; } }
                if (rs) { ss += __shfl_xor(ss, 16); ss += __shfl_xor(ss, 32); if (fq == 0) atomicAdd(rs + row, ss); } }
            asm volatile("" ::: "memory"); }
    }
};
struct EpiQKV {
    static constexpr bool PERM = true, AFTER_DRAIN = false;
    bf16_t *gq, *gk, *gv, *fq_, *fk, *fv; const float* rs;
    __device__ __forceinline__ void operator()(const f32x4 (&acc)[2][2][4][2], const Unit& u, int wr, int wc, int fr, int fq) const {
        bf16_t* base; int ldc, colt; const int pn = u.pn;
        if (pn < 4) { base = gq; ldc = 1024; colt = pn * 256; } else if (pn < 8) { base = gk; ldc = 1024; colt = (pn - 4) * 256; }
        else if (pn < 16) { base = gv; ldc = 2048; colt = (pn - 8) * 256; } else if (pn < 24) { base = fq_; ldc = 2048; colt = (pn - 16) * 256; }
        else if (pn < 32) { base = fk; ldc = 2048; colt = (pn - 24) * 256; } else { base = fv; ldc = 2048; colt = (pn - 32) * 256; }
        const int row0 = u.pm * BM + wr * 64 + fr, col0 = colt + wc * 32 + 8 * fq;
        const bool headmajor = pn >= 24;
#pragma unroll
        for (int ai = 0; ai < 2; ++ai)
#pragma unroll
            for (int m = 0; m < 4; ++m) { const int row = row0 + ai * HALF + m * 16;
                const float rstd = __builtin_amdgcn_rsqf(rs[row] * (1.0f / 2048.0f) + 1e-6f);
#pragma unroll
                for (int bj = 0; bj < 2; ++bj) { const f32x4 v0 = acc[ai][bj][m][0] * rstd, v1 = acc[ai][bj][m][1] * rstd;
                    u32x4 w; w.x = cvt_pk_bf16(v0[0], v0[1]); w.y = cvt_pk_bf16(v0[2], v0[3]); w.z = cvt_pk_bf16(v1[0], v1[1]); w.w = cvt_pk_bf16(v1[2], v1[3]);
                    bf16_t* dst = headmajor ? base + ((size_t)((row >> 13) * 16 + (colt >> 7) + bj) * 8192 + (row & 8191)) * 128 + wc * 32 + 8 * fq
                                            : base + (size_t)row * ldc + col0 + bj * HALF;
                    *(u32x4*)dst = w; } }
    }
};
struct EpiGates {
    static constexpr bool PERM = true, AFTER_DRAIN = false;
    bf16_t *agla, *afox, *sg, *sf; const float* osq; const float* gon; const float* bm; const float* rsx;
    __device__ __forceinline__ void operator()(const f32x4 (&acc)[2][2][4][2], const Unit& u, int wr, int wc, int fr, int fq) const {
        const int pn = u.pn, kind = pn >> 3, colt = (pn & 7) * 256;
        const int row0 = u.pm * BM + wr * 64 + fr, col0 = colt + wc * 32 + 8 * fq;
        bf16_t* base = kind == 0 ? agla : kind == 1 ? afox : kind == 2 ? sg : sf;
        f32x4 cv[2][2];
#pragma unroll
        for (int bj = 0; bj < 2; ++bj)
#pragma unroll
            for (int n = 0; n < 2; ++n) {
                if (kind == 0) cv[bj][n] = *(const f32x4*)(gon + col0 + bj * HALF + 4 * n);
                else if (kind >= 2) cv[bj][n] = *(const f32x4*)(bm + (kind - 2) * 2048 + col0 + bj * HALF + 4 * n);
                else cv[bj][n] = (f32x4){0.f, 0.f, 0.f, 0.f}; }
#pragma unroll
        for (int ai = 0; ai < 2; ++ai) {
            u32x4 ov[4][2]; float rstd[4], rso[4];
#pragma unroll
            for (int m = 0; m < 4; ++m) { const int row = row0 + ai * HALF + m * 16; rstd[m] = rsx[row]; rso[m] = 1.f;
                if (kind == 0) { const f32x4* pp = (const f32x4*)(osq + (size_t)row * 128 + (pn >> 1) * 32 + fq * 8); const f32x4 p = pp[0] + pp[1]; rso[m] = (p[0] + p[1]) + (p[2] + p[3]); }
#pragma unroll
                for (int bj = 0; bj < 2; ++bj) ov[m][bj] = kind <= 1 ? *(const u32x4*)(base + (size_t)row * 2048 + col0 + bj * HALF) : (u32x4){0u, 0u, 0u, 0u}; }
            asm volatile("" ::: "memory");
#pragma unroll
            for (int m = 0; m < 4; ++m) { const int row = row0 + ai * HALF + m * 16; bf16_t* rowp = base + (size_t)row * 2048 + col0;
                const float rs_x = __builtin_amdgcn_rsqf(rstd[m] * (1.0f / 2048.0f) + 1e-6f); float rs = 1.f;
                if (kind == 0) { float t = rso[m]; t += __shfl_xor(t, 16); t += __shfl_xor(t, 32); rs = __builtin_amdgcn_rsqf(t * (1.0f / 512.0f) + 1e-6f); }
#pragma unroll
                for (int bj = 0; bj < 2; ++bj) { const f32x4 v0 = acc[ai][bj][m][0] * rs_x, v1 = acc[ai][bj][m][1] * rs_x; float r[8];
                    if (kind <= 1) { const u32x4 o = ov[m][bj];
                        const float ovv[8] = {bf_lo(o.x), bf_hi(o.x), bf_lo(o.y), bf_hi(o.y), bf_lo(o.z), bf_hi(o.z), bf_lo(o.w), bf_hi(o.w)};
#pragma unroll
                        for (int i = 0; i < 4; ++i) {
                            if (kind == 0) { r[i] = ovv[i] * rs * cv[bj][0][i] * silu_f(v0[i]); r[4 + i] = ovv[4 + i] * rs * cv[bj][1][i] * silu_f(v1[i]); }
                            else { r[i] = ovv[i] * sigmoid_f(v0[i]); r[4 + i] = ovv[4 + i] * sigmoid_f(v1[i]); } }
                    } else {
#pragma unroll
                        for (int i = 0; i < 4; ++i) { r[i] = sigmoid_f(v0[i] + cv[bj][0][i]); r[4 + i] = sigmoid_f(v1[i] + cv[bj][1][i]); } }
                    u32x4 w; w.x = cvt_pk_bf16(r[0], r[1]); w.y = cvt_pk_bf16(r[2], r[3]); w.z = cvt_pk_bf16(r[4], r[5]); w.w = cvt_pk_bf16(r[6], r[7]);
                    *(u32x4*)(rowp + bj * HALF) = w; } }
            asm volatile("" ::: "memory"); }
    }
};
struct EpiGated {
    static constexpr bool PERM = true, AFTER_DRAIN = false;
    const bf16_t* sg; const bf16_t* sf; bf16_t* mg;
    __device__ __forceinline__ void operator()(const f32x4 (&acc)[2][2][4][2], const Unit& u, int wr, int wc, int fr, int fq) const {
        const bool fox = u.pn >= 8; const int pm = u.pm & 63, pn = u.pn & 7; const bf16_t* gate = fox ? sf : sg;
        const int row0 = pm * BM + wr * 64 + fr, col0 = pn * BM + wc * 32 + 8 * fq;
#pragma unroll
        for (int ai = 0; ai < 2; ++ai) {
            u32x4 gv[4][2], pv[4][2];
#pragma unroll
            for (int m = 0; m < 4; ++m)
#pragma unroll
                for (int bj = 0; bj < 2; ++bj) { const size_t off = (size_t)(row0 + ai * HALF + m * 16) * 2048 + col0 + bj * HALF;
                    gv[m][bj] = *(const u32x4*)(gate + off); pv[m][bj] = fox ? *(const u32x4*)(mg + off) : (u32x4){0u, 0u, 0u, 0u}; }
            asm volatile("" ::: "memory");
#pragma unroll
            for (int m = 0; m < 4; ++m)
#pragma unroll
                for (int bj = 0; bj < 2; ++bj) { const f32x4 v0 = acc[ai][bj][m][0], v1 = acc[ai][bj][m][1]; const size_t off = (size_t)(row0 + ai * HALF + m * 16) * 2048 + col0 + bj * HALF;
                    const u32x4 g = gv[m][bj], p = pv[m][bj];
                    float r[8] = {bf_lo(g.x) * v0[0], bf_hi(g.x) * v0[1], bf_lo(g.y) * v0[2], bf_hi(g.y) * v0[3], bf_lo(g.z) * v1[0], bf_hi(g.z) * v1[1], bf_lo(g.w) * v1[2], bf_hi(g.w) * v1[3]};
                    r[0] += bf_lo(p.x); r[1] += bf_hi(p.x); r[2] += bf_lo(p.y); r[3] += bf_hi(p.y); r[4] += bf_lo(p.z); r[5] += bf_hi(p.z); r[6] += bf_lo(p.w); r[7] += bf_hi(p.w);
                    u32x4 w; w.x = cvt_pk_bf16(r[0], r[1]); w.y = cvt_pk_bf16(r[2], r[3]); w.z = cvt_pk_bf16(r[4], r[5]); w.w = cvt_pk_bf16(r[6], r[7]);
                    *(u32x4*)(mg + off) = w; }
            asm volatile("" ::: "memory"); }
    }
};
struct PairOrder {
    StaticOrder so;
    __host__ __device__ void init(int M, int N, int G_, int c_, int wgm_) { so.init(M, N, G_, c_, wgm_); }
    __host__ __device__ bool next(int i, Unit& u) const { Unit b; if (!so.next(i >> 1, b)) return false; if (i & 1) { u.pm = b.pm; u.pn = b.pn + 8; } else { u.pm = b.pm + 64; u.pn = b.pn; } return true; }
    __device__ __forceinline__ void a_ready(const Unit&) const {}
    __device__ __forceinline__ void done(const Unit&) const {}
};
template <class Epi, class Sched, bool ALIGN_EPI = false, bool SP2 = false>
__device__ __forceinline__ void gemm_phase(PG8_LAS unsigned char* lds, const Gemm g, const Sched& S, const Epi& E, const int tid) {
    const int wid = __builtin_amdgcn_readfirstlane(tid >> 6), lane = tid & 63, wr = wid >> 2, wc = wid & 3, fr = lane & 15, fq = lane >> 4;
    const int K = g.K, nt = K / BK;
    unsigned voffA[2], voffB[2];
#pragma unroll
    for (int i = 0; i < 2; ++i) { int R, C; stage_rc(tid * 16 + i * 8192, R, C); const int Rb = Epi::PERM ? ((R & ~31) + perm32(R & 31)) : R;
        voffA[i] = (unsigned)(R * K + C) * 2u; voffB[i] = (unsigned)(Rb * K + C) * 2u; }
    const size_t kstep = (size_t)(BK * 2);
    const size_t hstep = (size_t)HALF * K * 2;
    const size_t tstep = 2 * hstep;
    const unsigned ldsw = (unsigned)wid * 1024u;
    const int aoff = lds_byte(wr * 64 + fr, fq * 8), boff = lds_byte(wc * 32 + fr, fq * 8);
#define PG8_SA(b, h) (((b) * 2 + (h)) * HTB)
#define PG8_SB(b, h) ((4 + (b) * 2 + (h)) * HTB)
#define PG8_STAGE(bufoff, gbase, voff) do { _Pragma("unroll") for (int _i = 0; _i < 2; ++_i) \
        __builtin_amdgcn_global_load_lds((const unsigned*)((const char*)(gbase) + (voff)[_i]), (PG8_LAS unsigned*)(lds + (bufoff) + ldsw + _i * 8192), 16, 0, 0); } while (0)
#define PG8_LDA(dst, b, h) do { _Pragma("unroll") for (int m = 0; m < 4; ++m) _Pragma("unroll") for (int k = 0; k < 2; ++k) dst[m][k] = *(const PG8_LAS bf16x8*)(lds + PG8_SA(b, h) + aoff + m * 2048 + k * 1024); } while (0)
#define PG8_LDB(dst, b, h) do { _Pragma("unroll") for (int n = 0; n < 2; ++n) _Pragma("unroll") for (int k = 0; k < 2; ++k) dst[n][k] = *(const PG8_LAS bf16x8*)(lds + PG8_SB(b, h) + boff + n * 2048 + k * 1024); } while (0)
#define PG8_MMA(ai, bj, At, Bt) do { __builtin_amdgcn_s_setprio(1); _Pragma("unroll") for (int m = 0; m < 4; ++m) _Pragma("unroll") for (int n = 0; n < 2; ++n) _Pragma("unroll") for (int k = 0; k < 2; ++k) \
        acc[ai][bj][m][n] = __builtin_amdgcn_mfma_f32_16x16x32_bf16(Bt[n][k], At[m][k], acc[ai][bj][m][n], 0, 0, 0); __builtin_amdgcn_s_setprio(0); } while (0)
#define PG8_WAIT_V(n) asm volatile("s_waitcnt vmcnt(" #n ")" ::: "memory")
#define PG8_WAIT_L(n) asm volatile("s_waitcnt lgkmcnt(" #n ")" ::: "memory")
#define PG8_BAR __builtin_amdgcn_s_barrier()
#define PG8_SCHED __builtin_amdgcn_sched_barrier(0)
    Unit cur, nxt; int ui = 0;
    if (!S.next(0, cur)) return;
    f32x4 acc[2][2][4][2];
#pragma unroll
    for (int a = 0; a < 2; ++a)
#pragma unroll
        for (int b = 0; b < 2; ++b)
#pragma unroll
            for (int m = 0; m < 4; ++m)
#pragma unroll
                for (int n = 0; n < 2; ++n) acc[a][b][m][n] = (f32x4){0.f, 0.f, 0.f, 0.f};
    bf16x8 At[4][2], B0[2][2], B1[2][2];
    const char* cA = (const char*)g.A + (size_t)cur.pm * tstep; const char* cB = (const char*)g.Bt + (size_t)cur.pn * tstep;
    S.a_ready(cur);
    if constexpr (SP2) {
        PG8_STAGE(PG8_SB(0, 0), cB, voffB); PG8_STAGE(PG8_SB(0, 1), cB + hstep, voffB); PG8_STAGE(PG8_SA(0, 0), cA, voffA); PG8_STAGE(PG8_SA(0, 1), cA + hstep, voffA);
        if (wr == 1) PG8_BAR;
        PG8_WAIT_V(2); PG8_BAR;
        PG8_STAGE(PG8_SB(1, 0), cB + kstep, voffB); PG8_STAGE(PG8_SA(1, 0), cA + kstep, voffA); PG8_STAGE(PG8_SB(1, 1), cB + hstep + kstep, voffB);
        PG8_WAIT_V(6); PG8_BAR;
    } else {
        PG8_STAGE(PG8_SB(0, 0), cB, voffB); PG8_STAGE(PG8_SA(0, 0), cA, voffA); PG8_STAGE(PG8_SB(0, 1), cB + hstep, voffB); PG8_STAGE(PG8_SA(0, 1), cA + hstep, voffA);
        if (wr == 1) PG8_BAR;
        PG8_WAIT_V(4); PG8_BAR;
        PG8_STAGE(PG8_SB(1, 0), cB + kstep, voffB); PG8_STAGE(PG8_SA(1, 0), cA + kstep, voffA); PG8_STAGE(PG8_SB(1, 1), cB + hstep + kstep, voffB);
        PG8_WAIT_V(6); PG8_BAR;
    }
    for (;;) {
        const bool has_next = S.next(ui + 1, nxt);
        const char* nA = has_next ? (const char*)g.A + (size_t)nxt.pm * tstep : cA; const char* nB = has_next ? (const char*)g.Bt + (size_t)nxt.pn * tstep : cB;
        for (int t = 0; t < nt; t += 2) {
            const bool last = (t == nt - 2);
            const char* a1 = cA + (size_t)(t + 1) * kstep;
            const char* a2 = last ? nA : cA + (size_t)(t + 2) * kstep; const char* b2 = last ? nB : cB + (size_t)(t + 2) * kstep;
            const char* a3 = a2 + kstep; const char* b3 = b2 + kstep;
            if (last && has_next) S.a_ready(nxt);
            if constexpr (SP2) {
            PG8_LDB(B0, 0, 0); PG8_LDB(B1, 0, 1); PG8_SCHED; PG8_LDA(At, 0, 0); PG8_STAGE(PG8_SA(1, 1), a1 + hstep, voffA);
            PG8_WAIT_V(8); PG8_WAIT_L(0); PG8_BAR; PG8_MMA(0, 0, At, B0); PG8_MMA(0, 1, At, B1); PG8_BAR; PG8_SCHED;
            PG8_LDA(At, 0, 1); PG8_STAGE(PG8_SB(0, 0), b2, voffB); PG8_STAGE(PG8_SB(0, 1), b2 + hstep, voffB); PG8_STAGE(PG8_SA(0, 0), a2, voffA);
            PG8_WAIT_V(8); PG8_WAIT_L(0); PG8_BAR; PG8_MMA(1, 0, At, B0); PG8_MMA(1, 1, At, B1); PG8_BAR; PG8_SCHED;
            PG8_LDB(B0, 1, 0); PG8_LDB(B1, 1, 1); PG8_SCHED; PG8_LDA(At, 1, 0); PG8_STAGE(PG8_SA(0, 1), a2 + hstep, voffA);
            PG8_WAIT_V(8); PG8_WAIT_L(0); PG8_BAR; PG8_MMA(0, 0, At, B0); PG8_MMA(0, 1, At, B1); PG8_BAR; PG8_SCHED;
            PG8_LDA(At, 1, 1); PG8_STAGE(PG8_SB(1, 0), b3, voffB); PG8_STAGE(PG8_SB(1, 1), b3 + hstep, voffB); PG8_STAGE(PG8_SA(1, 0), a3, voffA);
            PG8_WAIT_V(8); PG8_WAIT_L(0); PG8_BAR; PG8_MMA(1, 0, At, B0); PG8_MMA(1, 1, At, B1); PG8_BAR; PG8_SCHED;
            } else {
            PG8_LDB(B0, 0, 0); PG8_SCHED; PG8_LDA(At, 0, 0); PG8_STAGE(PG8_SA(1, 1), a1 + hstep, voffA);
            PG8_WAIT_L(8); PG8_BAR; PG8_WAIT_L(0); PG8_MMA(0, 0, At, B0); PG8_BAR; PG8_SCHED;
            PG8_LDB(B1, 0, 1); PG8_STAGE(PG8_SB(0, 0), b2, voffB);
            PG8_BAR; PG8_WAIT_L(0); PG8_MMA(0, 1, At, B1); PG8_BAR;
            PG8_LDA(At, 0, 1); PG8_STAGE(PG8_SA(0, 0), a2, voffA);
            PG8_BAR; PG8_WAIT_L(0); PG8_MMA(1, 0, At, B0); PG8_BAR; PG8_SCHED;
            PG8_STAGE(PG8_SB(0, 1), b2 + hstep, voffB);
            PG8_WAIT_V(6); PG8_BAR; PG8_MMA(1, 1, At, B1); PG8_BAR;
            PG8_LDB(B0, 1, 0); PG8_SCHED; PG8_LDA(At, 1, 0); PG8_STAGE(PG8_SA(0, 1), a2 + hstep, voffA);
            PG8_WAIT_L(8); PG8_BAR; PG8_WAIT_L(0); PG8_MMA(0, 0, At, B0); PG8_BAR; PG8_SCHED;
            PG8_LDB(B1, 1, 1); PG8_STAGE(PG8_SB(1, 0), b3, voffB);
            PG8_BAR; PG8_WAIT_L(0); PG8_MMA(0, 1, At, B1); PG8_BAR;
            PG8_LDA(At, 1, 1); PG8_STAGE(PG8_SA(1, 0), a3, voffA);
            PG8_BAR; PG8_WAIT_L(0); PG8_MMA(1, 0, At, B0); PG8_BAR; PG8_SCHED;
            PG8_STAGE(PG8_SB(1, 1), b3 + hstep, voffB);
            PG8_WAIT_V(6); PG8_BAR; PG8_MMA(1, 1, At, B1); PG8_BAR;
            }
        }
        if constexpr (ALIGN_EPI) { if (wr == 0) PG8_BAR; }
        if constexpr (!Epi::AFTER_DRAIN) { E(acc, cur, wr, wc, fr, fq); S.done(cur); }
        if (!has_next) break;
#pragma unroll
        for (int a = 0; a < 2; ++a)
#pragma unroll
            for (int b = 0; b < 2; ++b)
#pragma unroll
                for (int m = 0; m < 4; ++m)
#pragma unroll
                    for (int n = 0; n < 2; ++n) acc[a][b][m][n] = (f32x4){0.f, 0.f, 0.f, 0.f};
        cur = nxt; cA = nA; cB = nB; ++ui;
        if constexpr (ALIGN_EPI) { if (wr == 1) PG8_BAR; }
    }
    PG8_WAIT_V(0);
    if constexpr (!ALIGN_EPI) { if (wr == 0) PG8_BAR; }
    PG8_BAR;
    if constexpr (Epi::AFTER_DRAIN) { E.fused(acc, cur, wr, wc, fr, fq, lds, wid, lane); S.done(cur); }
#undef PG8_SA
#undef PG8_SB
#undef PG8_STAGE
#undef PG8_LDA
#undef PG8_LDB
#undef PG8_MMA
#undef PG8_WAIT_V
#undef PG8_WAIT_L
#undef PG8_BAR
#undef PG8_SCHED
}
}

namespace fox {
constexpr int D = 128, PITCH = 2048, PITCH_KV = 128, NW = 8, QBLK = 32, KVBLK = 64, QB = NW * QBLK;
constexpr int SHM_V = KVBLK * D * 2, SHM_K = KVBLK * D * 2;
constexpr int OFF_WS = 2 * SHM_V + 2 * SHM_K, OFF_BIAS = OFF_WS + NW * 64 * 4, LDS_BYTES = OFF_BIAS + 512;
constexpr float THR = 8.f;
using bf16 = __hip_bfloat16;
typedef short bf16x8 __attribute__((ext_vector_type(8)));
typedef short s16x4 __attribute__((ext_vector_type(4)));
typedef float f32x16 __attribute__((ext_vector_type(16)));
typedef float f32x4 __attribute__((ext_vector_type(4)));
typedef unsigned u32x4 __attribute__((ext_vector_type(4)));
#define KSWZ(row, colB) ((row) * 256 + ((colB) ^ (((row) & 7) << 4)))
#define SBAR() __builtin_amdgcn_sched_barrier(0)
__device__ __forceinline__ int v_st(int k, int c) { const int kk = (k & ~0xC) | ((k & 4) << 1) | ((k & 8) >> 1); return ((kk >> 3) * 4 + (c >> 5)) * 512 + ((kk & 7) * 32 + (c & 31)) * 2; }
__device__ __forceinline__ int v_rd_base(int lane) { return ((lane & 3) << 3) | (((lane >> 2) & 3) << 6) | (((lane >> 4) & 1) << 5) | (((lane >> 5) & 1) << 8); }
constexpr int v_rd_off(int d0, int ks, int half) { return d0 * 512 + ks * 4096 + half * 2048; }
__device__ __forceinline__ int crow(int r, int hi) { return (r & 3) + 8 * (r >> 2) + 4 * hi; }
__device__ __forceinline__ unsigned cvtpk(float lo, float hi) { unsigned r; asm volatile("v_cvt_pk_bf16_f32 %0, %1, %2" : "=v"(r) : "v"(lo), "v"(hi)); return r; }
__device__ __forceinline__ bf16x8 load8(const bf16* p) { return *reinterpret_cast<const bf16x8*>(p); }
__device__ __forceinline__ void mask_tile(f32x16& p0, f32x16& p1, int dq, unsigned W) {
    const float NEG = -__builtin_inff();
#pragma unroll
    for (int r = 0; r < 16; ++r) { const int c = (r & 3) + 8 * (r >> 2);
        if (c > dq) p0[r] = NEG;
        if (c + 32 > dq) p1[r] = NEG; }
}
__device__ __forceinline__ void add_bias(f32x16& p0, f32x16& p1, const float* bl) {
#pragma unroll
    for (int j = 0; j < 4; ++j) { const f32x4 b0 = *(const f32x4*)(bl + 8 * j), b1 = *(const f32x4*)(bl + 32 + 8 * j);
#pragma unroll
        for (int i = 0; i < 4; ++i) { p0[4 * j + i] += b0[i]; p1[4 * j + i] += b1[i]; } }
}
__device__ __forceinline__ void partialSM(f32x16& p0, f32x16& p1, float& m_reg, float& mn, float& alpha) {
    float pmax = p0[0]; for (int r = 1; r < 16; ++r) pmax = fmaxf(pmax, p0[r]); for (int r = 0; r < 16; ++r) pmax = fmaxf(pmax, p1[r]);
    { auto rr = __builtin_amdgcn_permlane32_swap(__float_as_uint(pmax), __float_as_uint(pmax), false, false);
      pmax = fmaxf(__uint_as_float(rr[0]), __uint_as_float(rr[1])); }
    if (__builtin_expect(__all((pmax - m_reg) <= THR), 1)) { mn = m_reg; alpha = 1.f; }
    else { mn = fmaxf(m_reg, pmax); alpha = __builtin_amdgcn_exp2f(m_reg - mn); m_reg = mn; }
    for (int r = 0; r < 16; ++r) p0[r] = p0[r] - mn; for (int r = 0; r < 16; ++r) p1[r] = p1[r] - mn;
    for (int r = 0; r < 16; ++r) p0[r] = __builtin_amdgcn_exp2f(p0[r]);
}
__device__ __forceinline__ void finishSM(f32x16& p0, f32x16& p1, float alpha, float& l_reg, bf16x8& pa0, bf16x8& pa1, bf16x8& pa2, bf16x8& pa3) {
    for (int r = 0; r < 16; ++r) p1[r] = __builtin_amdgcn_exp2f(p1[r]);
    float ps = 0; for (int r = 0; r < 16; ++r) ps += p0[r]; for (int r = 0; r < 16; ++r) ps += p1[r];
    { auto rr = __builtin_amdgcn_permlane32_swap(__float_as_uint(ps), __float_as_uint(ps), false, false);
      ps = __uint_as_float(rr[0]) + __uint_as_float(rr[1]); }
    l_reg = l_reg * alpha + ps;
#define PK4(P, B_, OUT) do { unsigned a0 = cvtpk(P[B_+0], P[B_+1]), a1 = cvtpk(P[B_+2], P[B_+3]);                          \
        unsigned b0 = cvtpk(P[B_+4], P[B_+5]), b1 = cvtpk(P[B_+6], P[B_+7]);                                             \
        auto r0 = __builtin_amdgcn_permlane32_swap(a0, b0, false, false); auto r1 = __builtin_amdgcn_permlane32_swap(a1, b1, false, false); \
        u32x4 w = {r0[0], r1[0], r0[1], r1[1]}; OUT = *reinterpret_cast<bf16x8*>(&w); } while (0)
    PK4(p0, 0, pa0); PK4(p0, 8, pa1); PK4(p1, 0, pa2); PK4(p1, 8, pa3);
#undef PK4
}
template <int KB>
__device__ __forceinline__ void qkt(f32x16& p0, f32x16& p1, const char* K_lds, const float* B_lds, int r32, int hi, const bf16x8* qr) {
    { const float* bl = B_lds + KB * 64 + 4 * hi;
#pragma unroll
      for (int j = 0; j < 4; ++j) { const f32x4 b0 = *(const f32x4*)(bl + 8 * j), b1 = *(const f32x4*)(bl + 32 + 8 * j);
#pragma unroll
          for (int i = 0; i < 4; ++i) { p0[4 * j + i] = b0[i]; p1[4 * j + i] = b1[i]; } } }
    const char* kb[4];
#pragma unroll
    for (int dd = 0; dd < 4; ++dd) kb[dd] = K_lds + KB * SHM_K + KSWZ(r32, (dd * 16 + hi * 8) * 2);
#pragma unroll
    for (int d0 = 0; d0 < 8; ++d0) { const char* a = kb[d0 & 3] + (d0 >> 2) * 128;
        bf16x8 b0 = *reinterpret_cast<const bf16x8*>(a);
        bf16x8 b1 = *reinterpret_cast<const bf16x8*>(a + 32 * 256);
        p0 = __builtin_amdgcn_mfma_f32_32x32x16_bf16(b0, qr[d0], p0, 0, 0, 0);
        p1 = __builtin_amdgcn_mfma_f32_32x32x16_bf16(b1, qr[d0], p1, 0, 0, 0); }
}
template <int VB>
__device__ __forceinline__ void pv_tile(f32x16* o, int vb0, bf16x8 pa0, bf16x8 pa1, bf16x8 pa2, bf16x8 pa3) {
#define TRRD(dst, off) asm volatile("ds_read_b64_tr_b16 %0, %1 offset:%2" : "=&v"(dst) : "v"(vb0), "i"(off) : "memory")
#define PV_D0(d0) do { s16x4 l0, l1, l2, l3, h0, h1, h2, h3; constexpr int b_ = VB * SHM_V + v_rd_off(d0, 0, 0); \
        TRRD(l0, b_); TRRD(h0, b_ + 2048); TRRD(l1, b_ + 4096); TRRD(h1, b_ + 6144); TRRD(l2, b_ + 8192); TRRD(h2, b_ + 10240); TRRD(l3, b_ + 12288); TRRD(h3, b_ + 14336); \
        asm volatile("s_waitcnt lgkmcnt(0)" ::: "memory"); SBAR();   \
        o[d0] = __builtin_amdgcn_mfma_f32_32x32x16_bf16(pa0, (bf16x8){l0[0], l0[1], l0[2], l0[3], h0[0], h0[1], h0[2], h0[3]}, o[d0], 0, 0, 0);   \
        o[d0] = __builtin_amdgcn_mfma_f32_32x32x16_bf16(pa1, (bf16x8){l1[0], l1[1], l1[2], l1[3], h1[0], h1[1], h1[2], h1[3]}, o[d0], 0, 0, 0);   \
        o[d0] = __builtin_amdgcn_mfma_f32_32x32x16_bf16(pa2, (bf16x8){l2[0], l2[1], l2[2], l2[3], h2[0], h2[1], h2[2], h2[3]}, o[d0], 0, 0, 0);   \
        o[d0] = __builtin_amdgcn_mfma_f32_32x32x16_bf16(pa3, (bf16x8){l3[0], l3[1], l3[2], l3[3], h3[0], h3[1], h3[2], h3[3]}, o[d0], 0, 0, 0); } while (0)
    PV_D0(0); PV_D0(1); PV_D0(2); PV_D0(3);
#undef PV_D0
#undef TRRD
}
struct Bases { bf16* Q; const bf16* K; const bf16* V; const float* NB; };
struct BlockRef { unsigned ro; int bh; int P0; };
#define RQ(R) (Bs.Q + (size_t)(R).ro + (size_t)(R).P0 * PITCH)
#define RK(R) (Bs.K + (size_t)(R).bh * (8192u * 128u))
#define RV(R) (Bs.V + (size_t)(R).bh * (8192u * 128u))
#define RNB(R) (Bs.NB + (size_t)(R).bh * 8192)
struct Seam { bf16x8 qr[8]; bf16x8 st_v0, st_v1, st_k0, st_k1; float st_b; };
#define ROWP(p, k0, rc) ((const bf16*)((const char*)((p) + ((size_t)(k0) + (rc)) * PITCH_KV) + toffB))
#define VMW() asm volatile("s_waitcnt vmcnt(0)" ::: "memory")
#define VMWN(n) asm volatile("s_waitcnt vmcnt(%0)" :: "i"(n) : "memory")
#define SLOAD_H(R, k0) do { S.st_v0 = load8(ROWP(RV(R), k0, 0)); S.st_v1 = load8(ROWP(RV(R), k0, 32));              \
                         S.st_k0 = load8(ROWP(RK(R), k0, 0)); S.st_k1 = load8(ROWP(RK(R), k0, 32)); S.st_b = RNB(R)[(k0) + (tid & 63)]; } while (0)
#define SWRITE_HK(bf) do { *(bf16x8*)(K_lds + (bf) * SHM_K + kws) = S.st_k0; *(bf16x8*)(K_lds + (bf) * SHM_K + kws + 32 * 256) = S.st_k1; \
                           if (tid < 64) B_lds[(bf) * 64 + tid] = S.st_b; } while (0)
#define SWRITE_HV(bf) do { *(bf16x8*)(V_lds + (bf) * SHM_V + vst0) = S.st_v0; *(bf16x8*)(V_lds + (bf) * SHM_V + vst1) = S.st_v1; } while (0)
#define SWRITE_H(bf) do { SWRITE_HV(bf); SWRITE_HK(bf); } while (0)
__device__ __forceinline__ void prime(const Bases& Bs, const BlockRef& cur, char* lds, Seam& S, const int tid) {
    const int wid = __builtin_amdgcn_readfirstlane(tid >> 6), lane = tid & 63, r32 = lane & 31, hi = lane >> 5;
    const int sr = tid >> 4, sc = (tid & 15) * 8, kws = KSWZ(sr, sc * 2); char* K_lds = lds + 2 * SHM_V; float* B_lds = (float*)(lds + OFF_BIAS);
    const unsigned toffB = (unsigned)(sr * PITCH_KV + sc) * 2u, qoffB = (unsigned)((wid * QBLK + r32) * PITCH + hi * 8) * 2u;
    for (int d0 = 0; d0 < 8; ++d0) S.qr[d0] = load8((const bf16*)((const char*)RQ(cur) + qoffB) + d0 * 16);
    SLOAD_H(cur, cur.P0 + QB - KVBLK); VMW(); SWRITE_HK(0);
    __syncthreads();
}
__device__ __forceinline__ void block(const Bases& Bs, const BlockRef& cur, const BlockRef& nxt, char* lds, Seam& S, const int tid) {
    const int wid = __builtin_amdgcn_readfirstlane(tid >> 6), lane = tid & 63, r32 = lane & 31, hi = lane >> 5;
    const unsigned W = 1u << 30;
    const int NT = (cur.P0 + QB) / KVBLK;
    const int qlo = cur.P0 + wid * QBLK;
    char* V_lds = lds; char* K_lds = lds + 2 * SHM_V; float* B_lds = (float*)(lds + OFF_BIAS);
    float* ws = (float*)(lds + OFF_WS) + wid * 64; float* li_l = ws, * al_l = ws + 32;
    float m_reg = -1e30f, l_reg = 0; f32x16 o[4] = {};
    const int sr = tid >> 4, sc = (tid & 15) * 8, vst0 = v_st(sr, sc), vst1 = v_st(32 + sr, sc), kws = KSWZ(sr, sc * 2);
    const unsigned toffB = (unsigned)(sr * PITCH_KV + sc) * 2u;
    const int vb0 = (int)(uintptr_t)V_lds + v_rd_base(lane);
#define RESC(a) do { if (__any((a) < 1.f)) { if (hi == 0) al_l[r32] = (a); asm volatile("s_waitcnt lgkmcnt(0)" ::: "memory");              \
                     for (int d_ = 0; d_ < 4; ++d_) for (int r = 0; r < 16; ++r) o[d_][r] *= al_l[crow(r, hi)]; } } while (0)
#define KBASE(t) ((NT - 1 - (t)) * KVBLK)
#define MASKT(P0_, P1_, t) do { const int kb_ = KBASE(t); if (kb_ + KVBLK - 1 > qlo) { int tm_ = tid; asm volatile("" : "+v"(tm_)); mask_tile(P0_, P1_, qlo + (tm_ & 31) - 4 * ((tm_ >> 5) & 1) - kb_, W); } } while (0)
    constexpr int NQL = 8;
#define SEAM_K0() do { VMWN(NQL); SWRITE_HK(0); SBAR(); } while (0)
    f32x16 pA0, pA1, pB0, pB1; float mnA, mnB, alA, alB; bf16x8 pa0, pa1, pa2, pa3;
    SWRITE_HV(0); SBAR();
    SLOAD_H(cur, KBASE(1));
    SBAR(); qkt<0>(pA0, pA1, K_lds, B_lds, r32, hi, S.qr);
    MASKT(pA0, pA1, 0); partialSM(pA0, pA1, m_reg, mnA, alA);
    { VMW(); SWRITE_H(1); }
    __syncthreads();
#define HALF_STEP(PX0, PX1, mnX, alX, PY0, PY1, alY, t, KB, VB, SB) do {                                                      \
        SBAR(); qkt<KB>(PX0, PX1, K_lds, B_lds, r32, hi, S.qr);                                             \
        finishSM(PY0, PY1, alY, l_reg, pa0, pa1, pa2, pa3); SBAR();                                                           \
        if ((t) + 1 < NT) { SLOAD_H(cur, KBASE((t) + 1)); SBAR(); }                                               \
        pv_tile<VB>(o, vb0, pa0, pa1, pa2, pa3); MASKT(PX0, PX1, (t)); partialSM(PX0, PX1, m_reg, mnX, alX);                                        \
        __syncthreads();                                                                                                      \
        if ((t) + 1 < NT) { VMW(); SWRITE_H(SB); }                                                                          \
        RESC(alX); __syncthreads(); } while (0)
    for (int t = 1; t + 1 < NT; t += 2) {
        HALF_STEP(pB0, pB1, mnB, alB, pA0, pA1, alA, t, 1, 0, 0);
        HALF_STEP(pA0, pA1, mnA, alA, pB0, pB1, alB, t + 1, 0, 1, 1);
    }
    constexpr bool even = true;
    if (even) { SBAR(); qkt<1>(pB0, pB1, K_lds, B_lds, r32, hi, S.qr); SBAR(); }
    SLOAD_H(nxt, nxt.P0 + QB - KVBLK); SBAR();
    int tq_ = tid; asm volatile("" : "+v"(tq_));
    const unsigned qoffB = (unsigned)(((tq_ >> 6) * QBLK + (tq_ & 31)) * PITCH + ((tq_ >> 5) & 1) * 8) * 2u;
#pragma unroll
    for (int d0 = 0; d0 < 8; ++d0) S.qr[d0] = load8((const bf16*)((const char*)RQ(nxt) + qoffB) + d0 * 16);
    SBAR();
    finishSM(pA0, pA1, alA, l_reg, pa0, pa1, pa2, pa3); SBAR();
    pv_tile<0>(o, vb0, pa0, pa1, pa2, pa3);
    if (even) { MASKT(pB0, pB1, NT - 1); partialSM(pB0, pB1, m_reg, mnB, alB); __syncthreads(); RESC(alB);
        finishSM(pB0, pB1, alB, l_reg, pa0, pa1, pa2, pa3); SBAR(); pv_tile<1>(o, vb0, pa0, pa1, pa2, pa3); }
    SBAR(); SEAM_K0();
    if (hi == 0) li_l[r32] = l_reg; asm volatile("s_waitcnt lgkmcnt(0)" ::: "memory");
    float rli[16];
#pragma unroll
    for (int r = 0; r < 16; ++r) rli[r] = __builtin_amdgcn_rcpf(li_l[crow(r, hi)]);
    int to_ = tid; asm volatile("" : "+v"(to_));
    const unsigned ooffB = (unsigned)(((to_ >> 6) * QBLK + 4 * ((to_ >> 5) & 1)) * PITCH + (to_ & 31)) * 2u;
    char* Ow = (char*)RQ(cur) + ooffB;
#pragma unroll
    for (int r = 0; r < 16; ++r) { const int orow0 = (r & 3) + 8 * (r >> 2);
#pragma unroll
        for (int d0 = 0; d0 < 4; ++d0) { const float v = o[d0][r] * rli[r];
            const float vn = __shfl_xor(v, 1);
            if ((r32 & 1) == 0) *(unsigned*)(Ow + (size_t)(orow0 * PITCH + d0 * 32) * 2) = cvtpk(v, vn); } }
    __syncthreads();
#undef RESC
#undef KBASE
#undef MASKT
#undef SEAM_K0
#undef HALF_STEP
}
#undef ROWP
#undef RQ
#undef RK
#undef RV
#undef RNB
#undef VMW
#undef VMWN
#undef SLOAD_H
#undef SWRITE_HK
#undef SWRITE_HV
#undef SWRITE_H
#undef KSWZ
#undef SBAR
}

#define LAS __attribute__((address_space(3)))
typedef unsigned short bf16_t;
typedef unsigned v4u __attribute__((ext_vector_type(4)));
typedef unsigned v2u __attribute__((ext_vector_type(2)));
typedef float f32x4 __attribute__((ext_vector_type(4)));
typedef short bf16x8 __attribute__((ext_vector_type(8)));
typedef short s16x4 __attribute__((ext_vector_type(4)));
#define LDS_WAIT() asm volatile("s_waitcnt lgkmcnt(0)" ::: "memory")

constexpr int NWAVES = 8;
constexpr int M = 16384, DM = 2048, DFF = 5632, T = 8192, NCH = 128;
constexpr int IN_W = 18464;
constexpr float EPS = 1e-6f;
constexpr size_t MiB = 1u << 20;
constexpr size_t WS_CTL = 0;
constexpr size_t WS_PS = 1 * MiB;
constexpr size_t WS_ACH = 3 * MiB;
constexpr size_t WS_NB = 4 * MiB;
constexpr size_t WS_OSQ = 530 * MiB;
constexpr size_t WS_RS = 6 * MiB;
constexpr size_t WS_WB = 8 * MiB;
constexpr size_t WS_WA = 40 * MiB;
constexpr size_t WS_XN = 114 * MiB;
constexpr size_t WS_FV = 178 * MiB, WS_FK = 242 * MiB, WS_FQ = 306 * MiB, WS_GV = 370 * MiB, WS_GQ = 434 * MiB, WS_GK = 466 * MiB, WS_KT = 498 * MiB, WS_END = 538 * MiB;
constexpr size_t WS_H = WS_FV;
constexpr size_t WS_MGF = WS_FV;
constexpr size_t WS_SG = WS_GQ, WS_SF = WS_FK;
constexpr int LDS_BYTES = 153600;

__device__ __forceinline__ unsigned f2bf(float f) { unsigned u = __builtin_bit_cast(unsigned, f); return (u + 0x7fffu + ((u >> 16) & 1u)) >> 16; }
__device__ __forceinline__ unsigned pk2(float lo, float hi) { return f2bf(lo) | (f2bf(hi) << 16); }
__device__ __forceinline__ float bfu(unsigned short h) { return __uint_as_float((unsigned)h << 16); }
__device__ __forceinline__ float wave_sum(float v) {
#pragma unroll
    for (int o = 1; o < 64; o <<= 1) v += __shfl_xor(v, o);
    return v;
}
__device__ __forceinline__ float logsig(float z) { return fminf(z, 0.f) - __logf(1.0f + __expf(-fabsf(z))); }

typedef float f32x2m __attribute__((ext_vector_type(2)));
__device__ __forceinline__ void tr_item(const float* W, int N, bf16_t* WT, int ldk, int k0, int drow0, int a0, int b0, int a1, int b1, const float* gk, LAS float* scr, int lane) {
    const int n = 2 * (lane & 31), within = n & 31; const int sa = (n >> 5) ? a1 : a0, sb = (n >> 5) ? b1 : b0; const int sc = (within < 16) ? sa + within : sb + (within - 16);
#pragma unroll 8
    for (int i = 0; i < 32; ++i) { const int kk = 2 * i + (lane >> 5); const float gg = gk ? gk[k0 + kk] : 1.0f;
        const f32x2m v = *(const f32x2m*)(W + (size_t)(k0 + kk) * N + sc); scr[kk * 65 + n] = v.x * gg; scr[kk * 65 + n + 1] = v.y * gg; }
    LDS_WAIT(); asm volatile("" ::: "memory");
    const int c = lane & 7;
#pragma unroll
    for (int j = 0; j < 8; ++j) { const int n2 = (lane >> 3) + 8 * j; const LAS float* s = scr + (8 * c) * 65 + n2;
        v4u o; o.x = pk2(s[0 * 65], s[1 * 65]); o.y = pk2(s[2 * 65], s[3 * 65]); o.z = pk2(s[4 * 65], s[5 * 65]); o.w = pk2(s[6 * 65], s[7 * 65]);
        *(v4u*)(WT + (size_t)(drow0 + n2) * ldk + k0 + 8 * c) = o; }
    LDS_WAIT(); asm volatile("" ::: "memory");
}
enum { CM_ID = 0, CM_SWIGLU = 1, CM_WIN = 2 };
__device__ __forceinline__ void conv_map(int mode, int d0, int& srcA, int& srcB) {
    if (mode == CM_ID) { srcA = d0; srcB = d0 + 16; }
    else if (mode == CM_SWIGLU) { const int tile = d0 >> 8, w = d0 & 255; srcA = (w >> 7) * DFF + tile * 128 + (w & 127); srcB = srcA + 16; }
    else { int s;
        if (d0 < 4096) s = d0;
        else if (d0 < 10240) s = 6160 + (d0 - 4096);
        else if (d0 < 12288) s = 4096 + (d0 - 10240);
        else if (d0 < 18432) s = 12320 + (d0 - 12288);
        else { srcA = 6144; srcB = 12304; return; }
        srcA = s; srcB = s + 16; }
}
__device__ __forceinline__ void conv_range(const float* W, int K, int N, bf16_t* WT, int ldk, int ndest, int mode, const float* gk, int& base, int gw, int NGW, LAS float* scr, int lane) {
    const int nblk = (ndest + 63) / 64, nitems = (K / 64) * nblk;
    int it = gw - (base % NGW); if (it < 0) it += NGW;
    for (; it < nitems; it += NGW) { const int kb = it / nblk, nb = it % nblk; int a0, b0, a1, b1; conv_map(mode, nb * 64, a0, b0); conv_map(mode, nb * 64 + 32, a1, b1);
        tr_item(W, N, WT, ldk, kb * 64, nb * 64, a0, b0, a1, b1, gk, scr, lane); }
    base += nitems;
}
__device__ __forceinline__ void rms_rows_bf16(const float* x, const float* g, bf16_t* out, int gw, int NGW, int lane) {
    f32x4 gv[8];
#pragma unroll
    for (int j = 0; j < 8; ++j) gv[j] = ((const f32x4*)g)[lane + 64 * j];
    f32x4 nx[8];
    if (gw < M) { const f32x4* xr = (const f32x4*)(x + (size_t)gw * DM) + lane;
#pragma unroll
        for (int j = 0; j < 8; ++j) nx[j] = xr[64 * j]; }
    for (int m = gw; m < M; m += NGW) {
        f32x4 v[8]; float s = 0.f;
#pragma unroll
        for (int j = 0; j < 8; ++j) v[j] = nx[j];
        if (m + NGW < M) { const f32x4* xr = (const f32x4*)(x + (size_t)(m + NGW) * DM) + lane;
#pragma unroll
            for (int j = 0; j < 8; ++j) nx[j] = xr[64 * j]; }
#pragma unroll
        for (int j = 0; j < 8; ++j) s += (v[j].x * v[j].x + v[j].y * v[j].y) + (v[j].z * v[j].z + v[j].w * v[j].w);
        const float rstd = __builtin_amdgcn_rsqf(wave_sum(s) * (1.f / DM) + EPS);
        v2u* o8 = (v2u*)(out + (size_t)m * DM) + lane;
#pragma unroll
        for (int j = 0; j < 8; ++j) { v2u w; w.x = pk2(v[j].x * rstd * gv[j].x, v[j].y * rstd * gv[j].y); w.y = pk2(v[j].z * rstd * gv[j].z, v[j].w * rstd * gv[j].w); o8[64 * j] = w; }
    }
}
__device__ __forceinline__ void rms_rows_f32(float* x, const float* g, int gw, int NGW, int lane) {
    f32x4 gv[8];
#pragma unroll
    for (int j = 0; j < 8; ++j) gv[j] = ((const f32x4*)g)[lane + 64 * j];
    f32x4 nx[8];
    if (gw < M) { const f32x4* xr = (const f32x4*)(x + (size_t)gw * DM) + lane;
#pragma unroll
        for (int j = 0; j < 8; ++j) nx[j] = xr[64 * j]; }
    for (int m = gw; m < M; m += NGW) {
        f32x4* xw = (f32x4*)(x + (size_t)m * DM) + lane; f32x4 v[8]; float s = 0.f;
#pragma unroll
        for (int j = 0; j < 8; ++j) v[j] = nx[j];
        if (m + NGW < M) { const f32x4* xr = (const f32x4*)(x + (size_t)(m + NGW) * DM) + lane;
#pragma unroll
            for (int j = 0; j < 8; ++j) nx[j] = xr[64 * j]; }
#pragma unroll
        for (int j = 0; j < 8; ++j) s += (v[j].x * v[j].x + v[j].y * v[j].y) + (v[j].z * v[j].z + v[j].w * v[j].w);
        const float rstd = __builtin_amdgcn_rsqf(wave_sum(s) * (1.f / DM) + EPS);
#pragma unroll
        for (int j = 0; j < 8; ++j) xw[64 * j] = v[j] * rstd * gv[j];
    }
}
__device__ __forceinline__ void small_proj(const bf16_t* XN, const bf16_t* Wsm, float* PS, const float* rs, LAS unsigned char* lds, int wg, int G, int wid, int lane) {
    const int n16 = lane & 15, kq = lane >> 4; LAS f32x4* red = (LAS f32x4*)lds;
    for (int item = wg; item < M / 64; item += G) {
        const int rg = wid & 3, kh = wid >> 2, row = item * 64 + rg * 16 + n16;
        const bf16_t* ap = XN + (size_t)row * DM + kh * 1024 + kq * 8;
        const bf16_t* bp0 = Wsm + (size_t)n16 * DM + kh * 1024 + kq * 8; const bf16_t* bp1 = bp0 + (size_t)16 * DM;
        f32x4 a0 = {0.f, 0.f, 0.f, 0.f}, a1 = {0.f, 0.f, 0.f, 0.f};
#pragma unroll 8
        for (int ks = 0; ks < 32; ++ks) { const bf16x8 a = *(const bf16x8*)(ap + ks * 32), b0 = *(const bf16x8*)(bp0 + ks * 32), b1 = *(const bf16x8*)(bp1 + ks * 32);
            a0 = __builtin_amdgcn_mfma_f32_16x16x32_bf16(a, b0, a0, 0, 0, 0); a1 = __builtin_amdgcn_mfma_f32_16x16x32_bf16(a, b1, a1, 0, 0, 0); }
        if (kh == 1) { red[(rg * 2 + 0) * 64 + lane] = a0; red[(rg * 2 + 1) * 64 + lane] = a1; }
        __syncthreads();
        if (kh == 0) { a0 += red[(rg * 2 + 0) * 64 + lane]; a1 += red[(rg * 2 + 1) * 64 + lane];
#pragma unroll
            for (int r = 0; r < 4; ++r) { const int row = item * 64 + rg * 16 + 4 * kq + r; const float rstd = __builtin_amdgcn_rsqf(rs[row] * (1.0f / 2048.0f) + 1e-6f); float* pr = PS + (size_t)row * 32; pr[n16] = a0[r] * rstd; pr[16 + n16] = a1[r] * rstd; } }
        __syncthreads();
    }
}
__device__ __forceinline__ void fox_qk_norm(bf16_t* FQ, bf16_t* FK, const float* gq, const float* gk, int gw, int NGW, int lane) {
    const int d = (lane & 15) * 8; float gqv[8], gkv[8];
#pragma unroll
    for (int i = 0; i < 8; ++i) { gqv[i] = gq[d + i] * (0.08838834764831845f * 1.4426950408889634f); gkv[i] = gk[d + i]; }
    v4u nx[2][4];
    if (gw < M) {
#pragma unroll
        for (int j = 0; j < 4; ++j) { nx[0][j] = *((const v4u*)(FQ + (size_t)gw * DM + j * 512) + lane); nx[1][j] = *((const v4u*)(FK + (size_t)gw * DM + j * 512) + lane); } }
    for (int m = gw; m < M; m += NGW) {
        v4u cur[2][4];
#pragma unroll
        for (int w = 0; w < 2; ++w)
#pragma unroll
            for (int j = 0; j < 4; ++j) cur[w][j] = nx[w][j];
        if (m + NGW < M) {
#pragma unroll
            for (int j = 0; j < 4; ++j) { nx[0][j] = *((const v4u*)(FQ + (size_t)(m + NGW) * DM + j * 512) + lane); nx[1][j] = *((const v4u*)(FK + (size_t)(m + NGW) * DM + j * 512) + lane); } }
#pragma unroll
        for (int which = 0; which < 2; ++which) { bf16_t* rowp = (which ? FK : FQ) + (size_t)m * DM;
#pragma unroll
            for (int j = 0; j < 4; ++j) { v4u* p = (v4u*)(rowp + j * 512) + lane; const v4u w = cur[which][j]; float v[8] = {__uint_as_float(w.x << 16), __uint_as_float(w.x & 0xffff0000u), __uint_as_float(w.y << 16), __uint_as_float(w.y & 0xffff0000u),
                    __uint_as_float(w.z << 16), __uint_as_float(w.z & 0xffff0000u), __uint_as_float(w.w << 16), __uint_as_float(w.w & 0xffff0000u)};
                float s = 0.f;
#pragma unroll
                for (int i = 0; i < 8; ++i) s += v[i] * v[i];
                s += __shfl_xor(s, 1); s += __shfl_xor(s, 2); s += __shfl_xor(s, 4); s += __shfl_xor(s, 8);
                const float rstd = __builtin_amdgcn_rsqf(s * (1.f / 128.f) + EPS);
                v4u o;
                if (which == 0) { o.x = pk2(v[0] * rstd * gqv[0], v[1] * rstd * gqv[1]); o.y = pk2(v[2] * rstd * gqv[2], v[3] * rstd * gqv[3]); o.z = pk2(v[4] * rstd * gqv[4], v[5] * rstd * gqv[5]); o.w = pk2(v[6] * rstd * gqv[6], v[7] * rstd * gqv[7]); }
                else { o.x = pk2(v[0] * rstd * gkv[0], v[1] * rstd * gkv[1]); o.y = pk2(v[2] * rstd * gkv[2], v[3] * rstd * gkv[3]); o.z = pk2(v[4] * rstd * gkv[4], v[5] * rstd * gkv[5]); o.w = pk2(v[6] * rstd * gkv[6], v[7] * rstd * gkv[7]); }
                *p = o; } }
    }
}
__device__ __forceinline__ void fox_cumsum(const float* PS, const float* b_f, float* NB, int bh, LAS unsigned char* lds, int wid, int lane) {
    const int b = bh >> 4, h = bh & 15; const float bf = b_f[h]; LAS float* tot = (LAS float*)lds;
    const int t0 = wid * 1024 + lane * 16;
    const float* src = PS + ((size_t)b * T + t0) * 32 + 16 + h;
    float ls[16]; float s = 0.f;
#pragma unroll
    for (int i = 0; i < 16; ++i) { ls[i] = logsig(src[(size_t)i * 32] + bf); s += ls[i]; }
    float incl = s;
#pragma unroll
    for (int o = 1; o < 64; o <<= 1) { const float t = __shfl_up(incl, o); if (lane >= o) incl += t; }
    if (lane == 63) tot[wid] = incl;
    __syncthreads();
    float run = incl - s;
#pragma unroll
    for (int w = 0; w < 8; ++w) if (w < wid) run += tot[w];
    float* dst = NB + (size_t)bh * T + t0;
#pragma unroll
    for (int q = 0; q < 4; ++q) { f32x4 o;
#pragma unroll
        for (int i = 0; i < 4; ++i) { run += ls[4 * q + i]; o[i] = -run * 1.4426950408889634f; }
        *(f32x4*)(dst + 4 * q) = o; }
    __syncthreads();
}
__device__ __forceinline__ void gla_prep_item(int item, const float* PS, const float* w_up, const float* b_a, const bf16_t* GK, bf16_t* KT, float* ACH, LAS unsigned char* lds, int tid) {
    const int h = item & 3, c = (item >> 2) & 127, b = item >> 9; const int col = tid & 255, half = tid >> 8;
    LAS float* alr_s = (LAS float*)lds; LAS float* tot_s = alr_s + 64 * 16;
    const size_t row0 = (size_t)b * T + (size_t)c * 64;
#pragma unroll
    for (int i = 0; i < 2; ++i) { const int e = tid + 512 * i; alr_s[e] = PS[(row0 + (e >> 4)) * 32 + (e & 15)]; }
    float w[16];
#pragma unroll
    for (int j = 0; j < 16; ++j) w[j] = w_up[j * 1024 + h * 256 + col];
    const float ba = b_a[h * 256 + col];
    __syncthreads();
    float Gv[32]; float run = 0.f;
#pragma unroll
    for (int r = 0; r < 32; ++r) { const LAS f32x4* ar = (const LAS f32x4*)(alr_s + (half * 32 + r) * 16); float z = ba;
#pragma unroll
        for (int q = 0; q < 4; ++q) { const f32x4 a = ar[q]; z += a.x * w[4 * q] + a.y * w[4 * q + 1] + a.z * w[4 * q + 2] + a.w * w[4 * q + 3]; }
        run += logsig(z) * (1.0f / 16.0f); Gv[r] = run; }
    tot_s[half * 256 + col] = run;
    __syncthreads();
    const float t0 = tot_s[col], t1 = tot_s[256 + col], Gend = t0 + t1, off = half ? t0 : 0.f;
    const bf16_t* kp = GK + (row0 + half * 32) * 1024 + h * 256 + col;
    unsigned pk[16];
#pragma unroll
    for (int r = 0; r < 32; r += 2) { const float k0 = bfu(kp[(size_t)r * 1024]) * __expf(Gend - (Gv[r] + off)), k1 = bfu(kp[(size_t)(r + 1) * 1024]) * __expf(Gend - (Gv[r + 1] + off)); pk[r >> 1] = pk2(k0, k1); }
    v4u* dst = (v4u*)(KT + ((((size_t)b * NCH + c) * 4 + h) * 256 + col) * 64 + half * 32);
#pragma unroll
    for (int q = 0; q < 4; ++q) dst[q] = (v4u){pk[4 * q], pk[4 * q + 1], pk[4 * q + 2], pk[4 * q + 3]};
    if (half == 0) ACH[((size_t)b * NCH + c) * 1024 + h * 256 + col] = __expf(Gend);
    __syncthreads();
}
constexpr int GL_K = 0, GL_Q = 32768, GL_A = 65536, GL_BUF = 66560, GL_X = 2 * GL_BUF, GL_END = GL_X + 16384;
__device__ __forceinline__ void gla_scan(int unit, const bf16_t* KT, const bf16_t* GQ, bf16_t* GV, const float* ACH, float* OSQ, LAS unsigned char* lds, int tid, int wid, int lane) {
    const int slab = unit & 7, h = (unit >> 3) & 3, b = unit >> 5; const int n16 = lane & 15, q4 = lane >> 4, dvg = wid & 3, dkh = wid >> 2;
    f32x4 S[8];
#pragma unroll
    for (int i = 0; i < 8; ++i) S[i] = (f32x4){0.f, 0.f, 0.f, 0.f};
    v4u rk[4], rq[4], ra; unsigned short rv[16];
    const size_t vcol = (size_t)h * 512 + slab * 64 + dvg * 16 + n16;
#define GL_LOAD(c) do { const bf16_t* kt = KT + (((size_t)b * NCH + (c)) * 4 + h) * 256 * 64; const bf16_t* qc = GQ + ((size_t)b * T + (size_t)(c) * 64) * 1024 + h * 256; \
        _Pragma("unroll") for (int i = 0; i < 4; ++i) { const int p = tid + 512 * i; rk[i] = *(const v4u*)(kt + (size_t)p * 8); rq[i] = *(const v4u*)(qc + (size_t)(p >> 5) * 1024 + (p & 31) * 8); } \
        if (tid < 64) ra = *(const v4u*)(ACH + ((size_t)b * NCH + (c)) * 1024 + h * 256 + tid * 4); \
        const bf16_t* vc = GV + ((size_t)b * T + (size_t)(c) * 64) * 2048 + vcol; \
        _Pragma("unroll") for (int i = 0; i < 16; ++i) rv[i] = vc[(size_t)((i >> 3) * 32 + 8 * q4 + (i & 7)) * 2048]; } while (0)
#define GL_STORE(buf) do { LAS unsigned char* bb = lds + (buf) * GL_BUF; \
        _Pragma("unroll") for (int i = 0; i < 4; ++i) { const int p = tid + 512 * i; *(LAS v4u*)(bb + GL_K + (p >> 3) * 128 + (((p & 7) ^ ((p >> 3) & 7)) * 16)) = rk[i]; *(LAS v4u*)(bb + GL_Q + (p >> 5) * 512 + (((p & 31) ^ ((p >> 5) & 15)) * 16)) = rq[i]; } \
        if (tid < 64) *(LAS v4u*)(bb + GL_A + tid * 16) = ra; } while (0)
    GL_LOAD(0); GL_STORE(0);
    __syncthreads();
    for (int c = 0; c < NCH; ++c) {
        const int buf = c & 1; LAS unsigned char* bb = lds + buf * GL_BUF;
        bf16x8 vf[2];
#pragma unroll
        for (int ks = 0; ks < 2; ++ks) { v4u w; w.x = rv[8 * ks] | ((unsigned)rv[8 * ks + 1] << 16); w.y = rv[8 * ks + 2] | ((unsigned)rv[8 * ks + 3] << 16); w.z = rv[8 * ks + 4] | ((unsigned)rv[8 * ks + 5] << 16); w.w = rv[8 * ks + 6] | ((unsigned)rv[8 * ks + 7] << 16); vf[ks] = __builtin_bit_cast(bf16x8, w); }
        if (c + 1 < NCH) GL_LOAD(c + 1);
#pragma unroll
        for (int i = 0; i < 8; ++i) { const int row = dkh * 128 + 16 * i + n16; const f32x4 av = *(const LAS f32x4*)(bb + GL_A + (dkh * 128 + 16 * i + 4 * q4) * 4); S[i] = S[i] * av;
#pragma unroll
            for (int ks = 0; ks < 2; ++ks) { const bf16x8 a = *(const LAS bf16x8*)(bb + GL_K + row * 128 + (((4 * ks + q4) ^ (n16 & 7)) * 16));
                S[i] = __builtin_amdgcn_mfma_f32_16x16x32_bf16(a, vf[ks], S[i], 0, 0, 0); } }
        f32x4 o[4];
#pragma unroll
        for (int ct = 0; ct < 4; ++ct) o[ct] = (f32x4){0.f, 0.f, 0.f, 0.f};
#pragma unroll
        for (int j = 0; j < 4; ++j) { v4u bw; bw.x = pg8::cvt_pk_bf16(S[2 * j][0], S[2 * j][1]); bw.y = pg8::cvt_pk_bf16(S[2 * j][2], S[2 * j][3]); bw.z = pg8::cvt_pk_bf16(S[2 * j + 1][0], S[2 * j + 1][1]); bw.w = pg8::cvt_pk_bf16(S[2 * j + 1][2], S[2 * j + 1][3]);
            const bf16x8 bfr = __builtin_bit_cast(bf16x8, bw);
#pragma unroll
            for (int ct = 0; ct < 4; ++ct) { const LAS unsigned char* qrow = bb + GL_Q + (16 * ct + n16) * 512;
                const int e0 = dkh * 32 + 8 * j + q4; const v2u lo = *(const LAS v2u*)(qrow + ((e0 ^ (n16 << 1)) * 8)), hi = *(const LAS v2u*)(qrow + (((e0 + 4) ^ (n16 << 1)) * 8)); const v4u aw = {lo.x, lo.y, hi.x, hi.y};
                o[ct] = __builtin_amdgcn_mfma_f32_16x16x32_bf16(__builtin_bit_cast(bf16x8, aw), bfr, o[ct], 0, 0, 0); } }
        LAS f32x4* xch = (LAS f32x4*)(lds + GL_X);
        if (dkh == 0) { xch[((dvg * 2 + 0) * 2 + 0) * 64 + lane] = o[2]; xch[((dvg * 2 + 0) * 2 + 1) * 64 + lane] = o[3]; }
        else          { xch[((dvg * 2 + 1) * 2 + 0) * 64 + lane] = o[0]; xch[((dvg * 2 + 1) * 2 + 1) * 64 + lane] = o[1]; }
        __syncthreads();
#pragma unroll
        for (int t = 0; t < 2; ++t) { const int ct = 2 * dkh + t; const f32x4 mine = dkh == 0 ? o[t] : o[2 + t]; const f32x4 s = mine + xch[((dvg * 2 + (1 - dkh)) * 2 + t) * 64 + lane];
            bf16_t* oc = GV + ((size_t)b * T + (size_t)c * 64 + 16 * ct + 4 * q4) * 2048 + vcol;
            float* osqp = OSQ + ((size_t)b * T + (size_t)c * 64 + 16 * ct + 4 * q4) * 128 + h * 32 + slab * 4 + dvg;
#pragma unroll
            for (int r = 0; r < 4; ++r) { const float v = s[r] * 0.0625f; float sq = v * v;
                sq += __shfl_xor(sq, 1); sq += __shfl_xor(sq, 2); sq += __shfl_xor(sq, 4); sq += __shfl_xor(sq, 8);
                if (n16 == 0) osqp[(size_t)r * 128] = sq;
                oc[(size_t)r * 2048] = (bf16_t)f2bf(v); } }
        if (c + 1 < NCH) GL_STORE(buf ^ 1);
        __syncthreads();
    }
#undef GL_LOAD
#undef GL_STORE
}

#define XB_TMO      128
#define XB_XCNT(j)  (256  + 64 * (j))
#define XB_XSUB(j)  (1280 + 64 * (j))
#define XB_XGEN(j)  (2304 + 64 * (j))
#define XB_TOP      3328
#define XB_TOPGEN   3392
#define XCD_BAR_WORDS 3456
#define XB_SPIN_CAP (1u << 18)

__device__ __forceinline__ unsigned xb_ld(unsigned* p)              { return __hip_atomic_load(p, __ATOMIC_RELAXED, __HIP_MEMORY_SCOPE_AGENT); }
__device__ __forceinline__ unsigned xb_add(unsigned* p, unsigned v) { return __hip_atomic_fetch_add(p, v, __ATOMIC_RELAXED, __HIP_MEMORY_SCOPE_AGENT); }
__device__ __forceinline__ unsigned xb_xcc_id() { return (unsigned)__builtin_amdgcn_s_getreg((3 << 11) | 20) & 0xFu; }
#define XB_SPIN(cond, bar) do { unsigned _sp = 0; while (cond) { __builtin_amdgcn_s_sleep(1); \
    if ((++_sp & 255u) == 0u) { if (xb_ld(&(bar)[XB_TMO])) break; if (_sp > XB_SPIN_CAP) { atomicAdd(&(bar)[XB_TMO], 1u); break; } } } } while (0)

struct XcdBarrier {
    unsigned* bar; unsigned x;
    volatile LAS unsigned* st;
};

__device__ __forceinline__ XcdBarrier xcd_barrier_post(unsigned* bar, volatile LAS unsigned* st) {
    XcdBarrier b; b.bar = bar; b.x = xb_xcc_id(); b.st = st;
    if (threadIdx.x == 0) (void)xb_add(&bar[XB_XCNT(b.x)], 1u);
    return b;
}
__device__ __forceinline__ void xcd_barrier_complete(unsigned* bar, unsigned x, unsigned& nloc, unsigned& nx) {
    const unsigned G = gridDim.x * gridDim.y * gridDim.z;
    unsigned sum, cnt, mine, sp = 0u;
    for (;;) {
        sum = 0u; cnt = 0u; mine = 0u;
#pragma unroll
        for (unsigned j = 0; j < 16; ++j) { const unsigned c = xb_ld(&bar[XB_XCNT(j)]); sum += c; cnt += (c > 0u) ? 1u : 0u; mine = (j == x) ? c : mine; }
        if (sum == G) break;
        __builtin_amdgcn_s_sleep(1);
        if ((++sp & 255u) == 0u) { if (xb_ld(&bar[XB_TMO])) break; if (sp > XB_SPIN_CAP) { atomicAdd(&bar[XB_TMO], 1u); break; } }
    }
    nloc = mine > 0u ? mine : 1u; nx = cnt > 0u ? cnt : 1u;
}

__device__ __forceinline__ void xcd_barrier(const XcdBarrier& b) {
    asm volatile("s_waitcnt vmcnt(0)" ::: "memory");
    __syncthreads();
    if (threadIdx.x == 0) {
        unsigned* bar = b.bar;
        __builtin_amdgcn_s_waitcnt(0);
        unsigned nloc = b.st[0], nx = b.st[1];
        if (nloc == 0u) { xcd_barrier_complete(bar, b.x, nloc, nx); b.st[0] = nloc; b.st[1] = nx; }
        const unsigned old = xb_add(&bar[XB_XSUB(b.x)], 1u);
        const unsigned gen = old / nloc;
        if (old + 1u == (gen + 1u) * nloc) {
            __builtin_amdgcn_fence(__ATOMIC_RELEASE, "agent");
            asm volatile("s_waitcnt vmcnt(0)" ::: "memory");
            const unsigned og = xb_add(&bar[XB_TOP], 1u);
            const unsigned tg = og / nx;
            if (og + 1u == (tg + 1u) * nx) xb_add(&bar[XB_TOPGEN], 1u);
            else XB_SPIN(xb_ld(&bar[XB_TOPGEN]) == tg, bar);
            __builtin_amdgcn_fence(__ATOMIC_ACQUIRE, "agent");
            xb_add(&bar[XB_XGEN(b.x)], 1u);
            asm volatile("s_waitcnt vmcnt(0)" ::: "memory");
        } else {
            XB_SPIN(xb_ld(&bar[XB_XGEN(b.x)]) == gen, bar);
            __builtin_amdgcn_fence(__ATOMIC_ACQUIRE, "agent");
            asm volatile("s_waitcnt vmcnt(0)" ::: "memory");
        }
    }
    __syncthreads();
}

constexpr int CW_BAR = 4096;
constexpr int LDS_MISC = LDS_BYTES - 64;
#ifndef PHMASK
#define PHMASK 0x3fff
#endif
struct Args { const float* in[20]; float* out; unsigned char* ws; int ph_lo, ph_hi; };
constexpr int N_PHASES = 14;
constexpr int N_GLA_UNITS = 64, N_ATT_ITEMS = 1024;

#define GP(T, p) ((T*)(__attribute__((address_space(1))) T*)(p))
#define PH_BEGIN \
        int tidp_ = threadIdx.x; asm volatile("" : "+v"(tidp_)); \
        const int tid = tidp_, lane = tid & 63, wid = __builtin_amdgcn_readfirstlane(tid >> 6); \
        const int G = gridDim.x, wg = blockIdx.x, gw = wg * NWAVES + wid, NGW = G * NWAVES; \
        __attribute__((address_space(1))) unsigned char* ws_ = (__attribute__((address_space(1))) unsigned char*)args.ws; asm volatile("" : "+s"(ws_)); unsigned char* ws = (unsigned char*)ws_; \
        float* out = GP(float, args.out); \
        bf16_t* XN = (bf16_t*)(ws + WS_XN); bf16_t* WA = (bf16_t*)(ws + WS_WA); bf16_t* H = (bf16_t*)(ws + WS_H); \
        bf16_t* Wbrg = (bf16_t*)(ws + WS_WB); bf16_t* Wbrf = Wbrg + (size_t)2048 * 2048; bf16_t* Wout2 = Wbrf + (size_t)2048 * 2048; \
        bf16_t *GQ = (bf16_t*)(ws + WS_GQ), *GK = (bf16_t*)(ws + WS_GK), *GV = (bf16_t*)(ws + WS_GV), *FQ = (bf16_t*)(ws + WS_FQ), *FK = (bf16_t*)(ws + WS_FK), *FV = (bf16_t*)(ws + WS_FV); \
        bf16_t *KT = (bf16_t*)(ws + WS_KT), *SG = (bf16_t*)(ws + WS_SG), *SF = (bf16_t*)(ws + WS_SF), *MGF = (bf16_t*)(ws + WS_MGF); \
        float *PS = (float*)(ws + WS_PS), *ACH = (float*)(ws + WS_ACH), *NB = (float*)(ws + WS_NB), *OSQ = (float*)(ws + WS_OSQ); \
        unsigned* ctl = (unsigned*)(ws + WS_CTL); float* RS1 = (float*)(ws + WS_RS); float* RS2 = RS1 + M; (void)RS1; (void)RS2; \
        LAS float* scr = (LAS float*)(lds + wid * 16640); \
        (void)lane; (void)gw; (void)NGW; (void)out; (void)XN; (void)WA; (void)H; (void)Wbrg; (void)Wbrf; (void)Wout2; (void)GQ; (void)GK; (void)GV; (void)FQ; (void)FK; (void)FV; (void)KT; (void)SG; (void)SF; (void)MGF; (void)PS; (void)ACH; (void)NB; (void)OSQ; (void)ctl; (void)scr;
#define IN(k) ((((PHMASK) >> (k)) & 1) && lo <= (k) && (k) < hi)
#define SEAM(k) do { if (lo <= (k) && (k) + 1 < hi) { if ((k) == 0) { __syncthreads(); grid.sync(); } else { xcd_barrier(xbar); } } } while (0)
#define GEMM_UP(rs_) do { pg8::Gemm g{XN, WA, M, 2 * DFF, DM}; pg8::StaticOrder S; S.init(M, 2 * DFF, G, wg); pg8::EpiSwiGLU E{H, DFF, rs_}; \
        pg8::gemm_phase<pg8::EpiSwiGLU, pg8::StaticOrder, true, true>(lds, g, S, E, tid); } while (0)
#define GEMM_RES(BASE_BF, OUT_BF, A_, B_, K_, base_, out_, scale_, rs_) do { pg8::Gemm g{A_, B_, M, DM, K_}; pg8::StaticOrder S; S.init(M, DM, G, wg, 4); pg8::EpiResid<BASE_BF, OUT_BF> E{(const void*)(base_), (void*)(out_), scale_, rs_}; \
        pg8::gemm_phase<pg8::EpiResid<BASE_BF, OUT_BF>, pg8::StaticOrder, true, true>(lds, g, S, E, tid); } while (0)

__global__ void __launch_bounds__(NWAVES * 64, 2) fwd_mega(Args args) {
    extern __shared__ __attribute__((aligned(16))) unsigned char lds_raw[];
    LAS unsigned char* lds = (LAS unsigned char*)lds_raw;
    cg::grid_group grid = cg::this_grid();
    const int lo = args.ph_lo, hi = args.ph_hi;
    { volatile LAS unsigned* misc = (volatile LAS unsigned*)(lds + LDS_MISC); if (threadIdx.x < 2) misc[threadIdx.x] = 0u; }
    __syncthreads();
    const XcdBarrier xbar = xcd_barrier_post((unsigned*)(GP(unsigned char, args.ws) + WS_CTL) + CW_BAR, (volatile LAS unsigned*)(lds + LDS_MISC));
    if (IN(0)) { PH_BEGIN
        int base = 0;
        if (wg == 0 && tid == 0) ctl[0] = 0u;
        for (int i = wg * 512 + tid; i < 2 * M; i += G * 512) RS1[i] = 0.f;
        conv_range(GP(const float, args.in[2]), DM, 2 * DFF, WA, DM, 2 * DFF, CM_SWIGLU, (const float*)nullptr, base, gw, NGW, scr, lane);
        conv_range(GP(const float, args.in[3]), DFF, DM, WA + (size_t)2 * DFF * DM, DFF, DM, CM_ID, (const float*)nullptr, base, gw, NGW, scr, lane);
        conv_range(GP(const float, args.in[12]), DM, DM, Wbrg, DM, DM, CM_ID, (const float*)nullptr, base, gw, NGW, scr, lane);
        conv_range(GP(const float, args.in[13]), DM, DM, Wbrf, DM, DM, CM_ID, (const float*)nullptr, base, gw, NGW, scr, lane);
        conv_range(GP(const float, args.in[15]), DM, DM, Wout2, DM, DM, CM_ID, (const float*)nullptr, base, gw, NGW, scr, lane);
        rms_rows_bf16(GP(const float, args.in[0]), GP(const float, args.in[1]), XN, gw, NGW, lane);
    }
    SEAM(0);
    if (IN(1)) { PH_BEGIN GEMM_UP((const float*)nullptr); }
    SEAM(1);
    if (IN(2)) { PH_BEGIN GEMM_RES(false, true, H, WA + (size_t)2 * DFF * DM, DFF, GP(const float, args.in[0]), XN, 0.5f, RS1); }
    SEAM(2);
    if (IN(3)) { PH_BEGIN
        int base = 0;
        conv_range(GP(const float, args.in[5]), DM, IN_W, WA, DM, IN_W, CM_WIN, GP(const float, args.in[4]), base, gw, NGW, scr, lane);
    }
    SEAM(3);
    if (IN(4)) {
        { PH_BEGIN small_proj(XN, WA + (size_t)18432 * DM, PS, RS1, lds, wg, G, wid, lane); }
        { PH_BEGIN
          pg8::Gemm g{XN, WA, M, 10240, DM}; pg8::StaticOrder S; S.init(M, 10240, G, wg);
          pg8::EpiQKV E{GQ, GK, GV, FQ, FK, FV, RS1};
          pg8::gemm_phase<pg8::EpiQKV, pg8::StaticOrder, true, true>(lds, g, S, E, tid); }
    }
    SEAM(4);
    if (IN(5)) { PH_BEGIN
        for (int item = wg; item < 2 * NCH * 4; item += G) gla_prep_item(item, PS, GP(const float, args.in[6]), GP(const float, args.in[7]), GK, KT, ACH, lds, tid);
        if (wg >= G - 32) fox_cumsum(PS, GP(const float, args.in[9]), NB, wg - (G - 32), lds, wid, lane);
        fox_qk_norm(FQ, FK, GP(const float, args.in[10]), GP(const float, args.in[11]), gw, NGW, lane);
    }
    SEAM(5);
    if (IN(6)) {
        if (blockIdx.x < N_GLA_UNITS) { PH_BEGIN gla_scan(wg, KT, GQ, GV, ACH, OSQ, lds, tid, wid, lane); __syncthreads(); }
        { PH_BEGIN
            LAS volatile int* nxt_s = (LAS volatile int*)(lds + fox::LDS_BYTES);
#define FOX_REF(i) ({ const int qb_ = 31 - ((i) >> 5), bh_ = (i) & 31; fox::BlockRef r_; r_.ro = (unsigned)(bh_ >> 4) * (unsigned)(T * DM) + (unsigned)(bh_ & 15) * 128u; r_.bh = bh_; r_.P0 = qb_ * 256; r_; })
            if (tid == 0) nxt_s[0] = (int)atomicAdd(ctl, 1u);
            __syncthreads();
            int cur_i = __builtin_amdgcn_readfirstlane(nxt_s[0]);
            if (cur_i < N_ATT_ITEMS) {
                const fox::Bases Bs{(fox::bf16*)FQ, (const fox::bf16*)FK, (const fox::bf16*)FV, NB};
                fox::BlockRef cur = FOX_REF(cur_i);
                fox::Seam Sm;
                fox::prime(Bs, cur, (char*)lds_raw, Sm, tid);
                for (;;) {
                    if (tid == 0) nxt_s[1] = (int)atomicAdd(ctl, 1u);
                    __syncthreads();
                    const int nxt_i = __builtin_amdgcn_readfirstlane(nxt_s[1]);
                    const fox::BlockRef nxt = nxt_i < N_ATT_ITEMS ? FOX_REF(nxt_i) : cur;
                    fox::block(Bs, cur, nxt, (char*)lds_raw, Sm, tid);
                    if (nxt_i >= N_ATT_ITEMS) break;
                    cur = nxt;
                }
            }
#undef FOX_REF
        }
    }
    SEAM(6);
    if (IN(7)) { PH_BEGIN
        pg8::Gemm g{XN, WA + (size_t)10240 * DM, M, 8192, DM}; pg8::StaticOrder S; S.init(M, 8192, G, wg);
        pg8::EpiGates E{GV, FQ, SG, SF, OSQ, GP(const float, args.in[8]), GP(const float, args.in[14]), RS1};
        pg8::gemm_phase<pg8::EpiGates, pg8::StaticOrder, true, true>(lds, g, S, E, tid);
    }
    SEAM(7);
    if (IN(8)) {
        { PH_BEGIN int base = 0;
          conv_range(GP(const float, args.in[17]), DM, 2 * DFF, WA, DM, 2 * DFF, CM_SWIGLU, GP(const float, args.in[16]), base, gw, NGW, scr, lane);
          conv_range(GP(const float, args.in[18]), DFF, DM, WA + (size_t)2 * DFF * DM, DFF, DM, CM_ID, (const float*)nullptr, base, gw, NGW, scr, lane);
          __syncthreads(); }
        { PH_BEGIN
          pg8::Gemm g{FQ, Wbrg, 2 * M, 2 * DM, DM};
          pg8::PairOrder S; S.init(M, DM, G, wg, 4);
          pg8::EpiGated E{SG, SF, MGF};
          pg8::gemm_phase<pg8::EpiGated, pg8::PairOrder, true, true>(lds, g, S, E, tid); }
    }
    SEAM(8);
    if (IN(9)) { PH_BEGIN GEMM_RES(true, true, MGF, Wout2, DM, XN, XN, 1.0f, RS2); }
    SEAM(9);
    if (IN(11)) { PH_BEGIN GEMM_UP((const float*)RS2); }
    SEAM(11);
    if (IN(12)) { PH_BEGIN GEMM_RES(true, false, H, WA + (size_t)2 * DFF * DM, DFF, XN, out, 0.5f, (float*)nullptr); }
    SEAM(12);
    if (IN(13)) { PH_BEGIN rms_rows_f32(out, GP(const float, args.in[19]), gw, NGW, lane); }
}

extern "C" void kernel_launch(void* const* d_in, const int* in_sizes, int n_in, void* d_out, int out_size, void* d_ws, size_t ws_size, hipStream_t stream) {
    static int grid = 0;
    if (grid == 0) {
        if (n_in != 20 || out_size != M * DM || ws_size < WS_END) { fprintf(stderr, "kernel_launch: unexpected shapes (n_in %d out %d ws %zu)\n", n_in, out_size, ws_size); grid = -1; return; }
        int dev = 0, cus = 0;
        (void)hipGetDevice(&dev); (void)hipDeviceGetAttribute(&cus, hipDeviceAttributeMultiprocessorCount, dev);
        (void)hipFuncSetAttribute((const void*)fwd_mega, hipFuncAttributeMaxDynamicSharedMemorySize, LDS_BYTES);
        int per_cu = 0;
        (void)hipOccupancyMaxActiveBlocksPerMultiprocessor(&per_cu, (const void*)fwd_mega, NWAVES * 64, LDS_BYTES);
        if (per_cu < 1) fprintf(stderr, "kernel_launch: occupancy query says %d blocks per CU\n", per_cu);
        (void)hipGetLastError();
        grid = cus > 0 ? cus : 256;
    }
    if (grid < 0) return;
    if (hipMemsetAsync((char*)d_ws + WS_CTL, 0, 65536, stream) != hipSuccess) { fprintf(stderr, "kernel_launch: memset of the control words failed\n"); return; }
    Args a{};
    for (int i = 0; i < 20; ++i) a.in[i] = (const float*)d_in[i];
    a.out = (float*)d_out; a.ws = (unsigned char*)d_ws;
#if MK_MULTI
    for (int ph = 0; ph < N_PHASES; ++ph) { a.ph_lo = ph; a.ph_hi = ph + 1; hipLaunchKernelGGL(fwd_mega, dim3(grid), dim3(NWAVES * 64), LDS_BYTES, stream, a); }
#else
    a.ph_lo = 0; a.ph_hi = N_PHASES;
    void* kargs[] = {&a};
    hipError_t e = hipLaunchCooperativeKernel((const void*)fwd_mega, dim3(grid), dim3(NWAVES * 64), kargs, LDS_BYTES, stream);
    if (e != hipSuccess) fprintf(stderr, "cooperative launch failed: %s (grid %d)\n", hipGetErrorString(e), grid);
#endif
}
```

```cpp
#include <hip/hip_runtime.h>
#include <hip/hip_bf16.h>
#include <hip/hip_cooperative_groups.h>
#include <cstdio>
#include <cstdint>
#ifndef MK_MULTI
#define MK_MULTI 0
#endif
namespace cg = cooperative_groups;
namespace pg8 {
#define PG8_LAS __attribute__((address_space(3)))
typedef unsigned short bf16_t;
typedef short bf16x8 __attribute__((ext_vector_type(8)));
typedef float f32x4 __attribute__((ext_vector_type(4)));
typedef unsigned u32x4 __attribute__((ext_vector_type(4)));
constexpr int BM = 256, BK = 64, HALF = 128, HTB = HALF * BK * 2  , STAGE_BYTES = 8 * HTB, NXCD = 8, WGM = 8;

__host__ __device__ __forceinline__ int lds_byte(int r, int c) { const int st = (r >> 4) * 2 + (c >> 5), rr = r & 15, cc = c & 31, ob = rr * 64 + cc * 2; return st * 1024 + (ob ^ (((ob >> 9) & 1) << 5)); }
__host__ __device__ __forceinline__ void stage_rc(int b, int& R, int& C) { const int st = b / 1024, sb = b % 1024, swz = sb ^ (((sb >> 9) & 1) << 5); R = (st >> 1) * 16 + swz / 64; C = (st & 1) * 32 + (swz % 64) / 2; }
__host__ __device__ __forceinline__ int perm32(int rho) { const int n = rho >> 4, i = rho & 15; return 8 * (i >> 2) + 4 * n + (i & 3); }

struct Unit { int pm, pn; };
struct Gemm { const bf16_t* A; const bf16_t* Bt; int M, N, K; };

struct StaticOrder {
    int nM, nN, nwg, G, c, wgm;
    __host__ __device__ void init(int M, int N, int G_, int c_, int wgm_ = WGM) { nM = M / BM; nN = N / BM; nwg = nM * nN; G = G_; c = c_; wgm = wgm_; }
    __host__ __device__ bool next(int i, Unit& u) const {
        const long L = (long)i * G + c; if (L >= nwg) return false;
        int wgid = (int)L; { const int q = nwg / NXCD, r = nwg % NXCD, xcd = wgid % NXCD, off = wgid / NXCD; wgid = (xcd < r ? xcd * (q + 1) : r * (q + 1) + (xcd - r) * q) + off; }
        const int nig = wgm * nN, gid = wgid / nig, fm = gid * wgm, gsz = (nM - fm) < wgm ? (nM - fm) : wgm;
        u.pm = fm + ((wgid % nig) % gsz); u.pn = (wgid % nig) / gsz; return true;
    }
    __device__ __forceinline__ void a_ready(const Unit&) const {}
    __device__ __forceinline__ void done(const Unit&) const {}
};

typedef float f32x2c_t __attribute__((ext_vector_type(2))); typedef __bf16 bf16x2c_t __attribute__((ext_vector_type(2)));
__device__ __forceinline__ unsigned cvt_pk_bf16(float lo, float hi) { const f32x2c_t v = {lo, hi}; const bf16x2c_t b = __builtin_convertvector(v, bf16x2c_t); return __builtin_bit_cast(unsigned, b); }
typedef float f32x2 __attribute__((ext_vector_type(2)));
__device__ __forceinline__ f32x2 gelu_pk(f32x2 v) {
    const f32x2 av = __builtin_elementwise_abs(v), d = av * 0.2316418882f + 1.0f;
    f32x2 t; t.x = __builtin_amdgcn_rcpf(d.x); t.y = __builtin_amdgcn_rcpf(d.y);
    f32x2 q = t * 0.5307027145f + (-0.7265760135f); q = q * t + 0.7107068705f; q = q * t + (-0.142248368f); q = q * t + 0.127414796f; q = q * t;
    const f32x2 s = (v * v) * (-0.72134752044f);
    f32x2 e; e.x = __builtin_amdgcn_exp2f(s.x); e.y = __builtin_amdgcn_exp2f(s.y);
    const f32x2 m = v * (q * e), r = v - m;
    f32x2 o; o.x = v.x < 0.f ? m.x : r.x; o.y = v.y < 0.f ? m.y : r.y; return o;
}

template <int ACT  > struct EpiBf16 {
    static constexpr bool PERM = true, AFTER_DRAIN = false; static_assert(ACT == 0 || ACT == 1, "EpiBf16: ACT is 0 (none) or 1 (gelu_pk)");
    bf16_t* O; int ldc; const float* bias; int split_cols; size_t split_stride; float scale0;
    __device__ __forceinline__ void operator()(const f32x4 (&acc)[2][2][4][2], const Unit& u, int wr, int wc, int fr, int fq) const {
        const int row0 = u.pm * BM + wr * 64 + fr; int colt = u.pn * BM; bf16_t* base = O;
        float sc = 1.f; if (split_cols) { const int t = colt / split_cols; base += (size_t)t * split_stride; colt -= t * split_cols; if (t == 0) sc = scale0; }
        const int col0 = colt + wc * 32 + 8 * fq, bcol0 = u.pn * BM + wc * 32 + 8 * fq;
        f32x4 bv[2][2];
#pragma unroll
        for (int bj = 0; bj < 2; ++bj)
#pragma unroll
            for (int n = 0; n < 2; ++n) bv[bj][n] = bias ? *(const f32x4*)(bias + bcol0 + bj * HALF + 4 * n) : (f32x4){0.f, 0.f, 0.f, 0.f};
#pragma unroll
        for (int ai = 0; ai < 2; ++ai)
#pragma unroll
            for (int m = 0; m < 4; ++m) { bf16_t* rowp = base + (size_t)(row0 + ai * HALF + m * 16) * ldc + col0;
#pragma unroll
                for (int bj = 0; bj < 2; ++bj) { f32x4 v0 = acc[ai][bj][m][0] + bv[bj][0], v1 = acc[ai][bj][m][1] + bv[bj][1];
                    if (ACT == 1) { f32x2 a = gelu_pk((f32x2){v0[0], v0[1]}), b = gelu_pk((f32x2){v0[2], v0[3]}), c = gelu_pk((f32x2){v1[0], v1[1]}), d = gelu_pk((f32x2){v1[2], v1[3]});
                        v0 = (f32x4){a.x, a.y, b.x, b.y}; v1 = (f32x4){c.x, c.y, d.x, d.y}; }
                    v0 = v0 * sc; v1 = v1 * sc; u32x4 w; w.x = cvt_pk_bf16(v0[0], v0[1]); w.y = cvt_pk_bf16(v0[2], v0[3]); w.z = cvt_pk_bf16(v1[0], v1[1]); w.w = cvt_pk_bf16(v1[2], v1[3]);
                    *(u32x4*)(rowp + bj * HALF) = w; } }
    }
};
__device__ __forceinline__ float sigmoid_f(float x) { return __builtin_amdgcn_rcpf(1.0f + __builtin_amdgcn_exp2f(-1.4426950408889634f * x)); }
__device__ __forceinline__ float silu_f(float x) { return x * sigmoid_f(x); }
__device__ __forceinline__ float bf_lo(unsigned w) { return __uint_as_float(w << 16); }
__device__ __forceinline__ float bf_hi(unsigned w) { return __uint_as_float(w & 0xffff0000u); }
typedef unsigned u32x2 __attribute__((ext_vector_type(2)));

struct EpiSwiGLU {
    static constexpr bool PERM = true, AFTER_DRAIN = false;
    bf16_t* H; int ldh; const float* rs;
    __device__ __forceinline__ void operator()(const f32x4 (&acc)[2][2][4][2], const Unit& u, int wr, int wc, int fr, int fq) const {
        const int row0 = u.pm * BM + wr * 64 + fr, col0 = u.pn * HALF + wc * 32 + 8 * fq;
#pragma unroll
        for (int ai = 0; ai < 2; ++ai)
#pragma unroll
            for (int m = 0; m < 4; ++m) {
                bf16_t* rowp = H + (size_t)(row0 + ai * HALF + m * 16) * ldh + col0;
                const float rstd = rs ? __builtin_amdgcn_rsqf(rs[row0 + ai * HALF + m * 16] * (1.0f / 2048.0f) + 1e-6f) : 1.0f;
                const f32x4 g0 = acc[ai][0][m][0] * rstd, g1 = acc[ai][0][m][1] * rstd, u0 = acc[ai][1][m][0] * rstd, u1 = acc[ai][1][m][1] * rstd;
                u32x4 w;
                w.x = cvt_pk_bf16(silu_f(g0[0]) * u0[0], silu_f(g0[1]) * u0[1]); w.y = cvt_pk_bf16(silu_f(g0[2]) * u0[2], silu_f(g0[3]) * u0[3]);
                w.z = cvt_pk_bf16(silu_f(g1[0]) * u1[0], silu_f(g1[1]) * u1[1]); w.w = cvt_pk_bf16(silu_f(g1[2]) * u1[2], silu_f(g1[3]) * u1[3]);
                *(u32x4*)rowp = w;
            }
    }
};
template <bool BASE_BF, bool OUT_BF> struct EpiResid {
    static constexpr bool PERM = true, AFTER_DRAIN = false;
    const void* base; void* out; float scale; float* rs;
    __device__ __forceinline__ void operator()(const f32x4 (&acc)[2][2][4][2], const Unit& u, int wr, int wc, int fr, int fq) const {
        const int row0 = u.pm * BM + wr * 64 + fr, col0 = u.pn * BM + wc * 32 + 8 * fq;
#pragma unroll
        for (int ai = 0; ai < 2; ++ai) {
            f32x4 bv[4][2][2];
#pragma unroll
            for (int m = 0; m < 4; ++m)
#pragma unroll
                for (int bj = 0; bj < 2; ++bj) { const size_t off = (size_t)(row0 + ai * HALF + m * 16) * 2048 + col0 + bj * HALF;
                    if (BASE_BF) { const u32x4 w = *(const u32x4*)((const bf16_t*)base + off); bv[m][bj][0] = (f32x4){bf_lo(w.x), bf_hi(w.x), bf_lo(w.y), bf_hi(w.y)}; bv[m][bj][1] = (f32x4){bf_lo(w.z), bf_hi(w.z), bf_lo(w.w), bf_hi(w.w)}; }
                    else { const float* bp = (const float*)base + off; bv[m][bj][0] = *(const f32x4*)bp; bv[m][bj][1] = *(const f32x4*)(bp + 4); } }
            asm volatile("" ::: "memory");
#pragma unroll
            for (int m = 0; m < 4; ++m) { const int row = row0 + ai * HALF + m * 16; float ss = 0.f;
#pragma unroll
                for (int bj = 0; bj < 2; ++bj) { const size_t off = (size_t)row * 2048 + col0 + bj * HALF;
                    const f32x4 y0 = bv[m][bj][0] + acc[ai][bj][m][0] * scale, y1 = bv[m][bj][1] + acc[ai][bj][m][1] * scale;
                    ss += ((y0[0] * y0[0] + y0[1] * y0[1]) + (y0[2] * y0[2] + y0[3] * y0[3])) + ((y1[0] * y1[0] + y1[1] * y1[1]) + (y1[2] * y1[2] + y1[3] * y1[3]));
                    if (OUT_BF) { u32x4 w; w.x = cvt_pk_bf16(y0[0], y0[1]); w.y = cvt_pk_bf16(y0[2], y0[3]); w.z = cvt_pk_bf16(y1[0], y1[1]); w.w = cvt_pk_bf16(y1[2], y1[3]); *(u32x4*)((bf16_t*)out + off) = w; }
                    else { float* op = (float*)out + off; *(f32x4*)op = y0; *(f32x4*)(op + 4) = y1; } }
                if (rs) { ss += __shfl_xor(ss, 16); ss += __shfl_xor(ss, 32); if (fq == 0) atomicAdd(rs + row, ss); } }
            asm volatile("" ::: "memory"); }
    }
};
struct EpiQKV {
    static constexpr bool PERM = true, AFTER_DRAIN = false;
    bf16_t *gq, *gk, *gv, *fq_, *fk, *fv; const float* rs;
    __device__ __forceinline__ void operator()(const f32x4 (&acc)[2][2][4][2], const Unit& u, int wr, int wc, int fr, int fq) const {
        bf16_t* base; int ldc, colt; const int pn = u.pn;
        if (pn < 4) { base = gq; ldc = 1024; colt = pn * 256; } else if (pn < 8) { base = gk; ldc = 1024; colt = (pn - 4) * 256; }
        else if (pn < 16) { base = gv; ldc = 2048; colt = (pn - 8) * 256; } else if (pn < 24) { base = fq_; ldc = 2048; colt = (pn - 16) * 256; }
        else if (pn < 32) { base = fk; ldc = 2048; colt = (pn - 24) * 256; } else { base = fv; ldc = 2048; colt = (pn - 32) * 256; }
        const int row0 = u.pm * BM + wr * 64 + fr, col0 = colt + wc * 32 + 8 * fq;
#pragma unroll
        for (int ai = 0; ai < 2; ++ai)
#pragma unroll
            for (int m = 0; m < 4; ++m) { bf16_t* rowp = base + (size_t)(row0 + ai * HALF + m * 16) * ldc + col0;
                const float rstd = __builtin_amdgcn_rsqf(rs[row0 + ai * HALF + m * 16] * (1.0f / 2048.0f) + 1e-6f);
#pragma unroll
                for (int bj = 0; bj < 2; ++bj) { const f32x4 v0 = acc[ai][bj][m][0] * rstd, v1 = acc[ai][bj][m][1] * rstd;
                    u32x4 w; w.x = cvt_pk_bf16(v0[0], v0[1]); w.y = cvt_pk_bf16(v0[2], v0[3]); w.z = cvt_pk_bf16(v1[0], v1[1]); w.w = cvt_pk_bf16(v1[2], v1[3]);
                    *(u32x4*)(rowp + bj * HALF) = w; } }
    }
};
struct EpiGates {
    static constexpr bool PERM = true, AFTER_DRAIN = false;
    bf16_t *agla, *afox, *sg, *sf; const float* osq; const float* gon; const float* bm; const float* rsx;
    __device__ __forceinline__ void operator()(const f32x4 (&acc)[2][2][4][2], const Unit& u, int wr, int wc, int fr, int fq) const {
        const int pn = u.pn, kind = pn >> 3, colt = (pn & 7) * 256;
        const int row0 = u.pm * BM + wr * 64 + fr, col0 = colt + wc * 32 + 8 * fq;
        bf16_t* base = kind == 0 ? agla : kind == 1 ? afox : kind == 2 ? sg : sf;
        f32x4 cv[2][2];
#pragma unroll
        for (int bj = 0; bj < 2; ++bj)
#pragma unroll
            for (int n = 0; n < 2; ++n) {
                if (kind == 0) cv[bj][n] = *(const f32x4*)(gon + col0 + bj * HALF + 4 * n);
                else if (kind >= 2) cv[bj][n] = *(const f32x4*)(bm + (kind - 2) * 2048 + col0 + bj * HALF + 4 * n);
                else cv[bj][n] = (f32x4){0.f, 0.f, 0.f, 0.f}; }
#pragma unroll
        for (int ai = 0; ai < 2; ++ai) {
            u32x4 ov[4][2]; float rstd[4], rso[4];
#pragma unroll
            for (int m = 0; m < 4; ++m) { const int row = row0 + ai * HALF + m * 16; rstd[m] = rsx[row]; rso[m] = 1.f;
                if (kind == 0) { const f32x4* pp = (const f32x4*)(osq + (size_t)row * 128 + (pn >> 1) * 32 + fq * 8); const f32x4 p = pp[0] + pp[1]; rso[m] = (p[0] + p[1]) + (p[2] + p[3]); }
#pragma unroll
                for (int bj = 0; bj < 2; ++bj) ov[m][bj] = kind <= 1 ? *(const u32x4*)(base + (size_t)row * 2048 + col0 + bj * HALF) : (u32x4){0u, 0u, 0u, 0u}; }
            asm volatile("" ::: "memory");
#pragma unroll
            for (int m = 0; m < 4; ++m) { const int row = row0 + ai * HALF + m * 16; bf16_t* rowp = base + (size_t)row * 2048 + col0;
                const float rs_x = __builtin_amdgcn_rsqf(rstd[m] * (1.0f / 2048.0f) + 1e-6f); float rs = 1.f;
                if (kind == 0) { float t = rso[m]; t += __shfl_xor(t, 16); t += __shfl_xor(t, 32); rs = __builtin_amdgcn_rsqf(t * (1.0f / 512.0f) + 1e-6f); }
#pragma unroll
                for (int bj = 0; bj < 2; ++bj) { const f32x4 v0 = acc[ai][bj][m][0] * rs_x, v1 = acc[ai][bj][m][1] * rs_x; float r[8];
                    if (kind <= 1) { const u32x4 o = ov[m][bj];
                        const float ovv[8] = {bf_lo(o.x), bf_hi(o.x), bf_lo(o.y), bf_hi(o.y), bf_lo(o.z), bf_hi(o.z), bf_lo(o.w), bf_hi(o.w)};
#pragma unroll
                        for (int i = 0; i < 4; ++i) {
                            if (kind == 0) { r[i] = ovv[i] * rs * cv[bj][0][i] * silu_f(v0[i]); r[4 + i] = ovv[4 + i] * rs * cv[bj][1][i] * silu_f(v1[i]); }
                            else { r[i] = ovv[i] * sigmoid_f(v0[i]); r[4 + i] = ovv[4 + i] * sigmoid_f(v1[i]); } }
                    } else {
#pragma unroll
                        for (int i = 0; i < 4; ++i) { r[i] = sigmoid_f(v0[i] + cv[bj][0][i]); r[4 + i] = sigmoid_f(v1[i] + cv[bj][1][i]); } }
                    u32x4 w; w.x = cvt_pk_bf16(r[0], r[1]); w.y = cvt_pk_bf16(r[2], r[3]); w.z = cvt_pk_bf16(r[4], r[5]); w.w = cvt_pk_bf16(r[6], r[7]);
                    *(u32x4*)(rowp + bj * HALF) = w; } }
            asm volatile("" ::: "memory"); }
    }
};
struct EpiGated {
    static constexpr bool PERM = true, AFTER_DRAIN = false;
    const bf16_t* sg; const bf16_t* sf; bf16_t* mg;
    __device__ __forceinline__ void operator()(const f32x4 (&acc)[2][2][4][2], const Unit& u, int wr, int wc, int fr, int fq) const {
        const bool fox = u.pn >= 8; const int pm = u.pm & 63, pn = u.pn & 7; const bf16_t* gate = fox ? sf : sg;
        const int row0 = pm * BM + wr * 64 + fr, col0 = pn * BM + wc * 32 + 8 * fq;
#pragma unroll
        for (int ai = 0; ai < 2; ++ai) {
            u32x4 gv[4][2], pv[4][2];
#pragma unroll
            for (int m = 0; m < 4; ++m)
#pragma unroll
                for (int bj = 0; bj < 2; ++bj) { const size_t off = (size_t)(row0 + ai * HALF + m * 16) * 2048 + col0 + bj * HALF;
                    gv[m][bj] = *(const u32x4*)(gate + off); pv[m][bj] = fox ? *(const u32x4*)(mg + off) : (u32x4){0u, 0u, 0u, 0u}; }
            asm volatile("" ::: "memory");
#pragma unroll
            for (int m = 0; m < 4; ++m)
#pragma unroll
                for (int bj = 0; bj < 2; ++bj) { const f32x4 v0 = acc[ai][bj][m][0], v1 = acc[ai][bj][m][1]; const size_t off = (size_t)(row0 + ai * HALF + m * 16) * 2048 + col0 + bj * HALF;
                    const u32x4 g = gv[m][bj], p = pv[m][bj];
                    float r[8] = {bf_lo(g.x) * v0[0], bf_hi(g.x) * v0[1], bf_lo(g.y) * v0[2], bf_hi(g.y) * v0[3], bf_lo(g.z) * v1[0], bf_hi(g.z) * v1[1], bf_lo(g.w) * v1[2], bf_hi(g.w) * v1[3]};
                    r[0] += bf_lo(p.x); r[1] += bf_hi(p.x); r[2] += bf_lo(p.y); r[3] += bf_hi(p.y); r[4] += bf_lo(p.z); r[5] += bf_hi(p.z); r[6] += bf_lo(p.w); r[7] += bf_hi(p.w);
                    u32x4 w; w.x = cvt_pk_bf16(r[0], r[1]); w.y = cvt_pk_bf16(r[2], r[3]); w.z = cvt_pk_bf16(r[4], r[5]); w.w = cvt_pk_bf16(r[6], r[7]);
                    *(u32x4*)(mg + off) = w; }
            asm volatile("" ::: "memory"); }
    }
};
struct PairOrder {
    StaticOrder so;
    __host__ __device__ void init(int M, int N, int G_, int c_, int wgm_) { so.init(M, N, G_, c_, wgm_); }
    __host__ __device__ bool next(int i, Unit& u) const { Unit b; if (!so.next(i >> 1, b)) return false; if (i & 1) { u.pm = b.pm; u.pn = b.pn + 8; } else { u.pm = b.pm + 64; u.pn = b.pn; } return true; }
    __device__ __forceinline__ void a_ready(const Unit&) const {}
    __device__ __forceinline__ void done(const Unit&) const {}
};
template <class Epi, class Sched, bool ALIGN_EPI = false, bool SP2 = false>
__device__ __forceinline__ void gemm_phase(PG8_LAS unsigned char* lds, const Gemm g, const Sched& S, const Epi& E, const int tid) {
    const int wid = __builtin_amdgcn_readfirstlane(tid >> 6), lane = tid & 63, wr = wid >> 2, wc = wid & 3, fr = lane & 15, fq = lane >> 4;
    const int K = g.K, nt = K / BK;
    unsigned voffA[2], voffB[2];
#pragma unroll
    for (int i = 0; i < 2; ++i) { int R, C; stage_rc(tid * 16 + i * 8192, R, C); const int Rb = Epi::PERM ? ((R & ~31) + perm32(R & 31)) : R;
        voffA[i] = (unsigned)(R * K + C) * 2u; voffB[i] = (unsigned)(Rb * K + C) * 2u; }
    const size_t kstep = (size_t)(BK * 2);
    const size_t hstep = (size_t)HALF * K * 2;
    const size_t tstep = 2 * hstep;
    const unsigned ldsw = (unsigned)wid * 1024u;
    const int aoff = lds_byte(wr * 64 + fr, fq * 8), boff = lds_byte(wc * 32 + fr, fq * 8);
#define PG8_SA(b, h) (((b) * 2 + (h)) * HTB)
#define PG8_SB(b, h) ((4 + (b) * 2 + (h)) * HTB)
#define PG8_STAGE(bufoff, gbase, voff) do { _Pragma("unroll") for (int _i = 0; _i < 2; ++_i) \
        __builtin_amdgcn_global_load_lds((const unsigned*)((const char*)(gbase) + (voff)[_i]), (PG8_LAS unsigned*)(lds + (bufoff) + ldsw + _i * 8192), 16, 0, 0); } while (0)
#define PG8_LDA(dst, b, h) do { _Pragma("unroll") for (int m = 0; m < 4; ++m) _Pragma("unroll") for (int k = 0; k < 2; ++k) dst[m][k] = *(const PG8_LAS bf16x8*)(lds + PG8_SA(b, h) + aoff + m * 2048 + k * 1024); } while (0)
#define PG8_LDB(dst, b, h) do { _Pragma("unroll") for (int n = 0; n < 2; ++n) _Pragma("unroll") for (int k = 0; k < 2; ++k) dst[n][k] = *(const PG8_LAS bf16x8*)(lds + PG8_SB(b, h) + boff + n * 2048 + k * 1024); } while (0)
#define PG8_MMA(ai, bj, At, Bt) do { __builtin_amdgcn_s_setprio(1); _Pragma("unroll") for (int m = 0; m < 4; ++m) _Pragma("unroll") for (int n = 0; n < 2; ++n) _Pragma("unroll") for (int k = 0; k < 2; ++k) \
        acc[ai][bj][m][n] = __builtin_amdgcn_mfma_f32_16x16x32_bf16(Bt[n][k], At[m][k], acc[ai][bj][m][n], 0, 0, 0); __builtin_amdgcn_s_setprio(0); } while (0)
#define PG8_WAIT_V(n) asm volatile("s_waitcnt vmcnt(" #n ")" ::: "memory")
#define PG8_WAIT_L(n) asm volatile("s_waitcnt lgkmcnt(" #n ")" ::: "memory")
#define PG8_BAR __builtin_amdgcn_s_barrier()
#define PG8_SCHED __builtin_amdgcn_sched_barrier(0)
    Unit cur, nxt; int ui = 0;
    if (!S.next(0, cur)) return;
    f32x4 acc[2][2][4][2];
#pragma unroll
    for (int a = 0; a < 2; ++a)
#pragma unroll
        for (int b = 0; b < 2; ++b)
#pragma unroll
            for (int m = 0; m < 4; ++m)
#pragma unroll
                for (int n = 0; n < 2; ++n) acc[a][b][m][n] = (f32x4){0.f, 0.f, 0.f, 0.f};
    bf16x8 At[4][2], B0[2][2], B1[2][2];
    const char* cA = (const char*)g.A + (size_t)cur.pm * tstep; const char* cB = (const char*)g.Bt + (size_t)cur.pn * tstep;
    S.a_ready(cur);
    if constexpr (SP2) {
        PG8_STAGE(PG8_SB(0, 0), cB, voffB); PG8_STAGE(PG8_SB(0, 1), cB + hstep, voffB); PG8_STAGE(PG8_SA(0, 0), cA, voffA); PG8_STAGE(PG8_SA(0, 1), cA + hstep, voffA);
        if (wr == 1) PG8_BAR;
        PG8_WAIT_V(2); PG8_BAR;
        PG8_STAGE(PG8_SB(1, 0), cB + kstep, voffB); PG8_STAGE(PG8_SA(1, 0), cA + kstep, voffA); PG8_STAGE(PG8_SB(1, 1), cB + hstep + kstep, voffB);
        PG8_WAIT_V(6); PG8_BAR;
    } else {
        PG8_STAGE(PG8_SB(0, 0), cB, voffB); PG8_STAGE(PG8_SA(0, 0), cA, voffA); PG8_STAGE(PG8_SB(0, 1), cB + hstep, voffB); PG8_STAGE(PG8_SA(0, 1), cA + hstep, voffA);
        if (wr == 1) PG8_BAR;
        PG8_WAIT_V(4); PG8_BAR;
        PG8_STAGE(PG8_SB(1, 0), cB + kstep, voffB); PG8_STAGE(PG8_SA(1, 0), cA + kstep, voffA); PG8_STAGE(PG8_SB(1, 1), cB + hstep + kstep, voffB);
        PG8_WAIT_V(6); PG8_BAR;
    }
    for (;;) {
        const bool has_next = S.next(ui + 1, nxt);
        const char* nA = has_next ? (const char*)g.A + (size_t)nxt.pm * tstep : cA; const char* nB = has_next ? (const char*)g.Bt + (size_t)nxt.pn * tstep : cB;
        for (int t = 0; t < nt; t += 2) {
            const bool last = (t == nt - 2);
            const char* a1 = cA + (size_t)(t + 1) * kstep;
            const char* a2 = last ? nA : cA + (size_t)(t + 2) * kstep; const char* b2 = last ? nB : cB + (size_t)(t + 2) * kstep;
            const char* a3 = a2 + kstep; const char* b3 = b2 + kstep;
            if (last && has_next) S.a_ready(nxt);
            if constexpr (SP2) {
            PG8_LDB(B0, 0, 0); PG8_LDB(B1, 0, 1); PG8_SCHED; PG8_LDA(At, 0, 0); PG8_STAGE(PG8_SA(1, 1), a1 + hstep, voffA);
            PG8_WAIT_V(8); PG8_WAIT_L(0); PG8_BAR; PG8_MMA(0, 0, At, B0); PG8_MMA(0, 1, At, B1); PG8_BAR; PG8_SCHED;
            PG8_LDA(At, 0, 1); PG8_STAGE(PG8_SB(0, 0), b2, voffB); PG8_STAGE(PG8_SB(0, 1), b2 + hstep, voffB); PG8_STAGE(PG8_SA(0, 0), a2, voffA);
            PG8_WAIT_V(8); PG8_WAIT_L(0); PG8_BAR; PG8_MMA(1, 0, At, B0); PG8_MMA(1, 1, At, B1); PG8_BAR; PG8_SCHED;
            PG8_LDB(B0, 1, 0); PG8_LDB(B1, 1, 1); PG8_SCHED; PG8_LDA(At, 1, 0); PG8_STAGE(PG8_SA(0, 1), a2 + hstep, voffA);
            PG8_WAIT_V(8); PG8_WAIT_L(0); PG8_BAR; PG8_MMA(0, 0, At, B0); PG8_MMA(0, 1, At, B1); PG8_BAR; PG8_SCHED;
            PG8_LDA(At, 1, 1); PG8_STAGE(PG8_SB(1, 0), b3, voffB); PG8_STAGE(PG8_SB(1, 1), b3 + hstep, voffB); PG8_STAGE(PG8_SA(1, 0), a3, voffA);
            PG8_WAIT_V(8); PG8_WAIT_L(0); PG8_BAR; PG8_MMA(1, 0, At, B0); PG8_MMA(1, 1, At, B1); PG8_BAR; PG8_SCHED;
            } else {
            PG8_LDB(B0, 0, 0); PG8_SCHED; PG8_LDA(At, 0, 0); PG8_STAGE(PG8_SA(1, 1), a1 + hstep, voffA);
            PG8_WAIT_L(8); PG8_BAR; PG8_WAIT_L(0); PG8_MMA(0, 0, At, B0); PG8_BAR; PG8_SCHED;
            PG8_LDB(B1, 0, 1); PG8_STAGE(PG8_SB(0, 0), b2, voffB);
            PG8_BAR; PG8_WAIT_L(0); PG8_MMA(0, 1, At, B1); PG8_BAR;
            PG8_LDA(At, 0, 1); PG8_STAGE(PG8_SA(0, 0), a2, voffA);
            PG8_BAR; PG8_WAIT_L(0); PG8_MMA(1, 0, At, B0); PG8_BAR; PG8_SCHED;
            PG8_STAGE(PG8_SB(0, 1), b2 + hstep, voffB);
            PG8_WAIT_V(6); PG8_BAR; PG8_MMA(1, 1, At, B1); PG8_BAR;
            PG8_LDB(B0, 1, 0); PG8_SCHED; PG8_LDA(At, 1, 0); PG8_STAGE(PG8_SA(0, 1), a2 + hstep, voffA);
            PG8_WAIT_L(8); PG8_BAR; PG8_WAIT_L(0); PG8_MMA(0, 0, At, B0); PG8_BAR; PG8_SCHED;
            PG8_LDB(B1, 1, 1); PG8_STAGE(PG8_SB(1, 0), b3, voffB);
            PG8_BAR; PG8_WAIT_L(0); PG8_MMA(0, 1, At, B1); PG8_BAR;
            PG8_LDA(At, 1, 1); PG8_STAGE(PG8_SA(1, 0), a3, voffA);
            PG8_BAR; PG8_WAIT_L(0); PG8_MMA(1, 0, At, B0); PG8_BAR; PG8_SCHED;
            PG8_STAGE(PG8_SB(1, 1), b3 + hstep, voffB);
            PG8_WAIT_V(6); PG8_BAR; PG8_MMA(1, 1, At, B1); PG8_BAR;
            }
        }
        if constexpr (ALIGN_EPI) { if (wr == 0) PG8_BAR; }
        if constexpr (!Epi::AFTER_DRAIN) { E(acc, cur, wr, wc, fr, fq); S.done(cur); }
        if (!has_next) break;
#pragma unroll
        for (int a = 0; a < 2; ++a)
#pragma unroll
            for (int b = 0; b < 2; ++b)
#pragma unroll
                for (int m = 0; m < 4; ++m)
#pragma unroll
                    for (int n = 0; n < 2; ++n) acc[a][b][m][n] = (f32x4){0.f, 0.f, 0.f, 0.f};
        cur = nxt; cA = nA; cB = nB; ++ui;
        if constexpr (ALIGN_EPI) { if (wr == 1) PG8_BAR; }
    }
    PG8_WAIT_V(0);
    if constexpr (!ALIGN_EPI) { if (wr == 0) PG8_BAR; }
    PG8_BAR;
    if constexpr (Epi::AFTER_DRAIN) { E.fused(acc, cur, wr, wc, fr, fq, lds, wid, lane); S.done(cur); }
#undef PG8_SA
#undef PG8_SB
#undef PG8_STAGE
#undef PG8_LDA
#undef PG8_LDB
#undef PG8_MMA
#undef PG8_WAIT_V
#undef PG8_WAIT_L
#undef PG8_BAR
#undef PG8_SCHED
}
}

namespace fox {
constexpr int D = 128, PITCH = 2048, NW = 8, QBLK = 32, KVBLK = 64, QB = NW * QBLK;
constexpr int SHM_V = KVBLK * D * 2, SHM_K = KVBLK * D * 2;
constexpr int OFF_WS = 2 * SHM_V + 2 * SHM_K, OFF_BIAS = OFF_WS + NW * 64 * 4, LDS_BYTES = OFF_BIAS + 512;
constexpr float THR = 8.f;
using bf16 = __hip_bfloat16;
typedef short bf16x8 __attribute__((ext_vector_type(8)));
typedef short s16x4 __attribute__((ext_vector_type(4)));
typedef float f32x16 __attribute__((ext_vector_type(16)));
typedef float f32x4 __attribute__((ext_vector_type(4)));
typedef unsigned u32x4 __attribute__((ext_vector_type(4)));
#define KSWZ(row, colB) ((row) * 256 + ((colB) ^ (((row) & 7) << 4)))
#define SBAR() __builtin_amdgcn_sched_barrier(0)
__device__ __forceinline__ int v_st(int k, int c) { const int kk = (k & ~0xC) | ((k & 4) << 1) | ((k & 8) >> 1); return ((kk >> 3) * 4 + (c >> 5)) * 512 + ((kk & 7) * 32 + (c & 31)) * 2; }
__device__ __forceinline__ int v_rd_base(int lane) { return ((lane & 3) << 3) | (((lane >> 2) & 3) << 6) | (((lane >> 4) & 1) << 5) | (((lane >> 5) & 1) << 8); }
constexpr int v_rd_off(int d0, int ks, int half) { return d0 * 512 + ks * 4096 + half * 2048; }
__device__ __forceinline__ int crow(int r, int hi) { return (r & 3) + 8 * (r >> 2) + 4 * hi; }
__device__ __forceinline__ unsigned cvtpk(float lo, float hi) { unsigned r; asm volatile("v_cvt_pk_bf16_f32 %0, %1, %2" : "=v"(r) : "v"(lo), "v"(hi)); return r; }
__device__ __forceinline__ bf16x8 load8(const bf16* p) { return *reinterpret_cast<const bf16x8*>(p); }
__device__ __forceinline__ void mask_tile(f32x16& p0, f32x16& p1, int dq, unsigned W) {
    const float NEG = -__builtin_inff();
#pragma unroll
    for (int r = 0; r < 16; ++r) { const int c = (r & 3) + 8 * (r >> 2);
        if (c > dq) p0[r] = NEG;
        if (c + 32 > dq) p1[r] = NEG; }
}
__device__ __forceinline__ void add_bias(f32x16& p0, f32x16& p1, const float* bl) {
#pragma unroll
    for (int j = 0; j < 4; ++j) { const f32x4 b0 = *(const f32x4*)(bl + 8 * j), b1 = *(const f32x4*)(bl + 32 + 8 * j);
#pragma unroll
        for (int i = 0; i < 4; ++i) { p0[4 * j + i] += b0[i]; p1[4 * j + i] += b1[i]; } }
}
__device__ __forceinline__ void partialSM(f32x16& p0, f32x16& p1, float& m_reg, float& mn, float& alpha) {
    float pmax = p0[0]; for (int r = 1; r < 16; ++r) pmax = fmaxf(pmax, p0[r]); for (int r = 0; r < 16; ++r) pmax = fmaxf(pmax, p1[r]);
    { auto rr = __builtin_amdgcn_permlane32_swap(__float_as_uint(pmax), __float_as_uint(pmax), false, false);
      pmax = fmaxf(__uint_as_float(rr[0]), __uint_as_float(rr[1])); }
    if (__builtin_expect(__all((pmax - m_reg) <= THR), 1)) { mn = m_reg; alpha = 1.f; }
    else { mn = fmaxf(m_reg, pmax); alpha = __builtin_amdgcn_exp2f(m_reg - mn); m_reg = mn; }
    for (int r = 0; r < 16; ++r) p0[r] = p0[r] - mn; for (int r = 0; r < 16; ++r) p1[r] = p1[r] - mn;
    for (int r = 0; r < 16; ++r) p0[r] = __builtin_amdgcn_exp2f(p0[r]);
}
__device__ __forceinline__ void finishSM(f32x16& p0, f32x16& p1, float alpha, float& l_reg, bf16x8& pa0, bf16x8& pa1, bf16x8& pa2, bf16x8& pa3) {
    for (int r = 0; r < 16; ++r) p1[r] = __builtin_amdgcn_exp2f(p1[r]);
    float ps = 0; for (int r = 0; r < 16; ++r) ps += p0[r]; for (int r = 0; r < 16; ++r) ps += p1[r];
    { auto rr = __builtin_amdgcn_permlane32_swap(__float_as_uint(ps), __float_as_uint(ps), false, false);
      ps = __uint_as_float(rr[0]) + __uint_as_float(rr[1]); }
    l_reg = l_reg * alpha + ps;
#define PK4(P, B_, OUT) do { unsigned a0 = cvtpk(P[B_+0], P[B_+1]), a1 = cvtpk(P[B_+2], P[B_+3]);                          \
        unsigned b0 = cvtpk(P[B_+4], P[B_+5]), b1 = cvtpk(P[B_+6], P[B_+7]);                                             \
        auto r0 = __builtin_amdgcn_permlane32_swap(a0, b0, false, false); auto r1 = __builtin_amdgcn_permlane32_swap(a1, b1, false, false); \
        u32x4 w = {r0[0], r1[0], r0[1], r1[1]}; OUT = *reinterpret_cast<bf16x8*>(&w); } while (0)
    PK4(p0, 0, pa0); PK4(p0, 8, pa1); PK4(p1, 0, pa2); PK4(p1, 8, pa3);
#undef PK4
}
template <int KB>
__device__ __forceinline__ void qkt(f32x16& p0, f32x16& p1, const char* K_lds, const float* B_lds, int r32, int hi, const bf16x8* qr) {
    { const float* bl = B_lds + KB * 64 + 4 * hi;
#pragma unroll
      for (int j = 0; j < 4; ++j) { const f32x4 b0 = *(const f32x4*)(bl + 8 * j), b1 = *(const f32x4*)(bl + 32 + 8 * j);
#pragma unroll
          for (int i = 0; i < 4; ++i) { p0[4 * j + i] = b0[i]; p1[4 * j + i] = b1[i]; } } }
    const char* kb[4];
#pragma unroll
    for (int dd = 0; dd < 4; ++dd) kb[dd] = K_lds + KB * SHM_K + KSWZ(r32, (dd * 16 + hi * 8) * 2);
#pragma unroll
    for (int d0 = 0; d0 < 8; ++d0) { const char* a = kb[d0 & 3] + (d0 >> 2) * 128;
        bf16x8 b0 = *reinterpret_cast<const bf16x8*>(a);
        bf16x8 b1 = *reinterpret_cast<const bf16x8*>(a + 32 * 256);
        p0 = __builtin_amdgcn_mfma_f32_32x32x16_bf16(b0, qr[d0], p0, 0, 0, 0);
        p1 = __builtin_amdgcn_mfma_f32_32x32x16_bf16(b1, qr[d0], p1, 0, 0, 0); }
}
template <int VB>
__device__ __forceinline__ void pv_tile(f32x16* o, int vb0, bf16x8 pa0, bf16x8 pa1, bf16x8 pa2, bf16x8 pa3) {
#define TRRD(dst, off) asm volatile("ds_read_b64_tr_b16 %0, %1 offset:%2" : "=&v"(dst) : "v"(vb0), "i"(off) : "memory")
#define PV_D0(d0) do { s16x4 l0, l1, l2, l3, h0, h1, h2, h3; constexpr int b_ = VB * SHM_V + v_rd_off(d0, 0, 0); \
        TRRD(l0, b_); TRRD(h0, b_ + 2048); TRRD(l1, b_ + 4096); TRRD(h1, b_ + 6144); TRRD(l2, b_ + 8192); TRRD(h2, b_ + 10240); TRRD(l3, b_ + 12288); TRRD(h3, b_ + 14336); \
        asm volatile("s_waitcnt lgkmcnt(0)" ::: "memory"); SBAR();   \
        o[d0] = __builtin_amdgcn_mfma_f32_32x32x16_bf16(pa0, (bf16x8){l0[0], l0[1], l0[2], l0[3], h0[0], h0[1], h0[2], h0[3]}, o[d0], 0, 0, 0);   \
        o[d0] = __builtin_amdgcn_mfma_f32_32x32x16_bf16(pa1, (bf16x8){l1[0], l1[1], l1[2], l1[3], h1[0], h1[1], h1[2], h1[3]}, o[d0], 0, 0, 0);   \
        o[d0] = __builtin_amdgcn_mfma_f32_32x32x16_bf16(pa2, (bf16x8){l2[0], l2[1], l2[2], l2[3], h2[0], h2[1], h2[2], h2[3]}, o[d0], 0, 0, 0);   \
        o[d0] = __builtin_amdgcn_mfma_f32_32x32x16_bf16(pa3, (bf16x8){l3[0], l3[1], l3[2], l3[3], h3[0], h3[1], h3[2], h3[3]}, o[d0], 0, 0, 0); } while (0)
    PV_D0(0); PV_D0(1); PV_D0(2); PV_D0(3);
#undef PV_D0
#undef TRRD
}
struct Bases { bf16* Q; const bf16* K; const bf16* V; const float* NB; };
struct BlockRef { unsigned ro; int bh; int P0; };
#define RQ(R) (Bs.Q + (size_t)(R).ro + (size_t)(R).P0 * PITCH)
#define RK(R) (Bs.K + (size_t)(R).ro)
#define RV(R) (Bs.V + (size_t)(R).ro)
#define RNB(R) (Bs.NB + (size_t)(R).bh * 8192)
struct Seam { bf16x8 qr[8]; bf16x8 st_v0, st_v1, st_k0, st_k1; float st_b; };
#define ROWP(p, k0, rc) ((const bf16*)((const char*)((p) + ((size_t)(k0) + (rc)) * PITCH) + toffB))
#define VMW() asm volatile("s_waitcnt vmcnt(0)" ::: "memory")
#define VMWN(n) asm volatile("s_waitcnt vmcnt(%0)" :: "i"(n) : "memory")
#define SLOAD_H(R, k0) do { S.st_v0 = load8(ROWP(RV(R), k0, 0)); S.st_v1 = load8(ROWP(RV(R), k0, 32));              \
                         S.st_k0 = load8(ROWP(RK(R), k0, 0)); S.st_k1 = load8(ROWP(RK(R), k0, 32)); S.st_b = RNB(R)[(k0) + (tid & 63)]; } while (0)
#define SWRITE_HK(bf) do { *(bf16x8*)(K_lds + (bf) * SHM_K + kws) = S.st_k0; *(bf16x8*)(K_lds + (bf) * SHM_K + kws + 32 * 256) = S.st_k1; \
                           if (tid < 64) B_lds[(bf) * 64 + tid] = S.st_b; } while (0)
#define SWRITE_HV(bf) do { *(bf16x8*)(V_lds + (bf) * SHM_V + vst0) = S.st_v0; *(bf16x8*)(V_lds + (bf) * SHM_V + vst1) = S.st_v1; } while (0)
#define SWRITE_H(bf) do { SWRITE_HV(bf); SWRITE_HK(bf); } while (0)
__device__ __forceinline__ void prime(const Bases& Bs, const BlockRef& cur, char* lds, Seam& S, const int tid) {
    const int wid = __builtin_amdgcn_readfirstlane(tid >> 6), lane = tid & 63, r32 = lane & 31, hi = lane >> 5;
    const int sr = tid >> 4, sc = (tid & 15) * 8, kws = KSWZ(sr, sc * 2); char* K_lds = lds + 2 * SHM_V; float* B_lds = (float*)(lds + OFF_BIAS);
    const unsigned toffB = (unsigned)(sr * PITCH + sc) * 2u, qoffB = (unsigned)((wid * QBLK + r32) * PITCH + hi * 8) * 2u;
    for (int d0 = 0; d0 < 8; ++d0) S.qr[d0] = load8((const bf16*)((const char*)RQ(cur) + qoffB) + d0 * 16);
    SLOAD_H(cur, cur.P0 + QB - KVBLK); VMW(); SWRITE_HK(0);
    __syncthreads();
}
__device__ __forceinline__ void block(const Bases& Bs, const BlockRef& cur, const BlockRef& nxt, char* lds, Seam& S, const int tid) {
    const int wid = __builtin_amdgcn_readfirstlane(tid >> 6), lane = tid & 63, r32 = lane & 31, hi = lane >> 5;
    const unsigned W = 1u << 30;
    const int NT = (cur.P0 + QB) / KVBLK;
    const int qlo = cur.P0 + wid * QBLK;
    char* V_lds = lds; char* K_lds = lds + 2 * SHM_V; float* B_lds = (float*)(lds + OFF_BIAS);
    float* ws = (float*)(lds + OFF_WS) + wid * 64; float* li_l = ws, * al_l = ws + 32;
    float m_reg = -1e30f, l_reg = 0; f32x16 o[4] = {};
    const int sr = tid >> 4, sc = (tid & 15) * 8, vst0 = v_st(sr, sc), vst1 = v_st(32 + sr, sc), kws = KSWZ(sr, sc * 2);
    const unsigned toffB = (unsigned)(sr * PITCH + sc) * 2u;
    const int vb0 = (int)(uintptr_t)V_lds + v_rd_base(lane);
#define RESC(a) do { if (__any((a) < 1.f)) { if (hi == 0) al_l[r32] = (a); asm volatile("s_waitcnt lgkmcnt(0)" ::: "memory");              \
                     for (int d_ = 0; d_ < 4; ++d_) for (int r = 0; r < 16; ++r) o[d_][r] *= al_l[crow(r, hi)]; } } while (0)
#define KBASE(t) ((NT - 1 - (t)) * KVBLK)
#define MASKT(P0_, P1_, t) do { const int kb_ = KBASE(t); if (kb_ + KVBLK - 1 > qlo) { int tm_ = tid; asm volatile("" : "+v"(tm_)); mask_tile(P0_, P1_, qlo + (tm_ & 31) - 4 * ((tm_ >> 5) & 1) - kb_, W); } } while (0)
    constexpr int NQL = 8;
#define SEAM_K0() do { VMWN(NQL); SWRITE_HK(0); SBAR(); } while (0)
    f32x16 pA0, pA1, pB0, pB1; float mnA, mnB, alA, alB; bf16x8 pa0, pa1, pa2, pa3;
    SWRITE_HV(0); SBAR();
    SLOAD_H(cur, KBASE(1));
    SBAR(); qkt<0>(pA0, pA1, K_lds, B_lds, r32, hi, S.qr);
    MASKT(pA0, pA1, 0); partialSM(pA0, pA1, m_reg, mnA, alA);
    { VMW(); SWRITE_H(1); }
    __syncthreads();
#define HALF_STEP(PX0, PX1, mnX, alX, PY0, PY1, alY, t, KB, VB, SB) do {                                                      \
        SBAR(); qkt<KB>(PX0, PX1, K_lds, B_lds, r32, hi, S.qr);                                             \
        finishSM(PY0, PY1, alY, l_reg, pa0, pa1, pa2, pa3); SBAR();                                                           \
        if ((t) + 1 < NT) { SLOAD_H(cur, KBASE((t) + 1)); SBAR(); }                                               \
        pv_tile<VB>(o, vb0, pa0, pa1, pa2, pa3); MASKT(PX0, PX1, (t)); partialSM(PX0, PX1, m_reg, mnX, alX);                                        \
        __syncthreads();                                                                                                      \
        if ((t) + 1 < NT) { VMW(); SWRITE_H(SB); }                                                                          \
        RESC(alX); __syncthreads(); } while (0)
    for (int t = 1; t + 1 < NT; t += 2) {
        HALF_STEP(pB0, pB1, mnB, alB, pA0, pA1, alA, t, 1, 0, 0);
        HALF_STEP(pA0, pA1, mnA, alA, pB0, pB1, alB, t + 1, 0, 1, 1);
    }
    constexpr bool even = true;
    if (even) { SBAR(); qkt<1>(pB0, pB1, K_lds, B_lds, r32, hi, S.qr); SBAR(); }
    SLOAD_H(nxt, nxt.P0 + QB - KVBLK); SBAR();
    int tq_ = tid; asm volatile("" : "+v"(tq_));
    const unsigned qoffB = (unsigned)(((tq_ >> 6) * QBLK + (tq_ & 31)) * PITCH + ((tq_ >> 5) & 1) * 8) * 2u;
#pragma unroll
    for (int d0 = 0; d0 < 8; ++d0) S.qr[d0] = load8((const bf16*)((const char*)RQ(nxt) + qoffB) + d0 * 16);
    SBAR();
    finishSM(pA0, pA1, alA, l_reg, pa0, pa1, pa2, pa3); SBAR();
    pv_tile<0>(o, vb0, pa0, pa1, pa2, pa3);
    if (even) { MASKT(pB0, pB1, NT - 1); partialSM(pB0, pB1, m_reg, mnB, alB); __syncthreads(); RESC(alB);
        finishSM(pB0, pB1, alB, l_reg, pa0, pa1, pa2, pa3); SBAR(); pv_tile<1>(o, vb0, pa0, pa1, pa2, pa3); }
    SBAR(); SEAM_K0();
    if (hi == 0) li_l[r32] = l_reg; asm volatile("s_waitcnt lgkmcnt(0)" ::: "memory");
    float rli[16];
#pragma unroll
    for (int r = 0; r < 16; ++r) rli[r] = __builtin_amdgcn_rcpf(li_l[crow(r, hi)]);
    int to_ = tid; asm volatile("" : "+v"(to_));
    const unsigned ooffB = (unsigned)(((to_ >> 6) * QBLK + 4 * ((to_ >> 5) & 1)) * PITCH + (to_ & 31)) * 2u;
    char* Ow = (char*)RQ(cur) + ooffB;
#pragma unroll
    for (int r = 0; r < 16; ++r) { const int orow0 = (r & 3) + 8 * (r >> 2);
#pragma unroll
        for (int d0 = 0; d0 < 4; ++d0) { const float v = o[d0][r] * rli[r];
            const float vn = __shfl_xor(v, 1);
            if ((r32 & 1) == 0) *(unsigned*)(Ow + (size_t)(orow0 * PITCH + d0 * 32) * 2) = cvtpk(v, vn); } }
    __syncthreads();
#undef RESC
#undef KBASE
#undef MASKT
#undef SEAM_K0
#undef HALF_STEP
}
#undef ROWP
#undef RQ
#undef RK
#undef RV
#undef RNB
#undef VMW
#undef VMWN
#undef SLOAD_H
#undef SWRITE_HK
#undef SWRITE_HV
#undef SWRITE_H
#undef KSWZ
#undef SBAR
}

#define LAS __attribute__((address_space(3)))
typedef unsigned short bf16_t;
typedef unsigned v4u __attribute__((ext_vector_type(4)));
typedef unsigned v2u __attribute__((ext_vector_type(2)));
typedef float f32x4 __attribute__((ext_vector_type(4)));
typedef short bf16x8 __attribute__((ext_vector_type(8)));
typedef short s16x4 __attribute__((ext_vector_type(4)));
#define LDS_WAIT() asm volatile("s_waitcnt lgkmcnt(0)" ::: "memory")

constexpr int NWAVES = 8;
constexpr int M = 16384, DM = 2048, DFF = 5632, T = 8192, NCH = 128;
constexpr int IN_W = 18464;
constexpr float EPS = 1e-6f;
constexpr size_t MiB = 1u << 20;
constexpr size_t WS_CTL = 0;
constexpr size_t WS_PS = 1 * MiB;
constexpr size_t WS_ACH = 3 * MiB;
constexpr size_t WS_NB = 4 * MiB;
constexpr size_t WS_OSQ = 530 * MiB;
constexpr size_t WS_RS = 6 * MiB;
constexpr size_t WS_WB = 8 * MiB;
constexpr size_t WS_WA = 40 * MiB;
constexpr size_t WS_XN = 114 * MiB;
constexpr size_t WS_FV = 178 * MiB, WS_FK = 242 * MiB, WS_FQ = 306 * MiB, WS_GV = 370 * MiB, WS_GQ = 434 * MiB, WS_GK = 466 * MiB, WS_KT = 498 * MiB, WS_END = 538 * MiB;
constexpr size_t WS_H = WS_FV;
constexpr size_t WS_MGF = WS_FV;
constexpr size_t WS_SG = WS_GQ, WS_SF = WS_FK;
constexpr int LDS_BYTES = 153600;

__device__ __forceinline__ unsigned f2bf(float f) { unsigned u = __builtin_bit_cast(unsigned, f); return (u + 0x7fffu + ((u >> 16) & 1u)) >> 16; }
__device__ __forceinline__ unsigned pk2(float lo, float hi) { return f2bf(lo) | (f2bf(hi) << 16); }
__device__ __forceinline__ float bfu(unsigned short h) { return __uint_as_float((unsigned)h << 16); }
__device__ __forceinline__ float wave_sum(float v) {
#pragma unroll
    for (int o = 1; o < 64; o <<= 1) v += __shfl_xor(v, o);
    return v;
}
__device__ __forceinline__ float logsig(float z) { return fminf(z, 0.f) - __logf(1.0f + __expf(-fabsf(z))); }

typedef float f32x2m __attribute__((ext_vector_type(2)));
__device__ __forceinline__ void tr_item(const float* W, int N, bf16_t* WT, int ldk, int k0, int drow0, int a0, int b0, int a1, int b1, const float* gk, LAS float* scr, int lane) {
    const int n = 2 * (lane & 31), within = n & 31; const int sa = (n >> 5) ? a1 : a0, sb = (n >> 5) ? b1 : b0; const int sc = (within < 16) ? sa + within : sb + (within - 16);
#pragma unroll 8
    for (int i = 0; i < 32; ++i) { const int kk = 2 * i + (lane >> 5); const float gg = gk ? gk[k0 + kk] : 1.0f;
        const f32x2m v = __builtin_nontemporal_load((const f32x2m*)(W + (size_t)(k0 + kk) * N + sc));     scr[kk * 65 + n] = v.x * gg; scr[kk * 65 + n + 1] = v.y * gg; }
    LDS_WAIT(); asm volatile("" ::: "memory");
    const int c = lane & 7;
#pragma unroll
    for (int j = 0; j < 8; ++j) { const int n2 = (lane >> 3) + 8 * j; const LAS float* s = scr + (8 * c) * 65 + n2;
        v4u o; o.x = pk2(s[0 * 65], s[1 * 65]); o.y = pk2(s[2 * 65], s[3 * 65]); o.z = pk2(s[4 * 65], s[5 * 65]); o.w = pk2(s[6 * 65], s[7 * 65]);
        *(v4u*)(WT + (size_t)(drow0 + n2) * ldk + k0 + 8 * c) = o; }
    LDS_WAIT(); asm volatile("" ::: "memory");
}
enum { CM_ID = 0, CM_SWIGLU = 1, CM_WIN = 2 };
__device__ __forceinline__ void conv_map(int mode, int d0, int& srcA, int& srcB) {
    if (mode == CM_ID) { srcA = d0; srcB = d0 + 16; }
    else if (mode == CM_SWIGLU) { const int tile = d0 >> 8, w = d0 & 255; srcA = (w >> 7) * DFF + tile * 128 + (w & 127); srcB = srcA + 16; }
    else { int s;
        if (d0 < 4096) s = d0;
        else if (d0 < 10240) s = 6160 + (d0 - 4096);
        else if (d0 < 12288) s = 4096 + (d0 - 10240);
        else if (d0 < 18432) s = 12320 + (d0 - 12288);
        else { srcA = 6144; srcB = 12304; return; }
        srcA = s; srcB = s + 16; }
}
__device__ __forceinline__ void conv_range(const float* W, int K, int N, bf16_t* WT, int ldk, int ndest, int mode, const float* gk, int& base, int gw, int NGW, LAS float* scr, int lane) {
    const int nblk = (ndest + 63) / 64, nitems = (K / 64) * nblk;
    int it = gw - (base % NGW); if (it < 0) it += NGW;
    for (; it < nitems; it += NGW) { const int kb = it / nblk, nb = it % nblk; int a0, b0, a1, b1; conv_map(mode, nb * 64, a0, b0); conv_map(mode, nb * 64 + 32, a1, b1);
        tr_item(W, N, WT, ldk, kb * 64, nb * 64, a0, b0, a1, b1, gk, scr, lane); }
    base += nitems;
}
__device__ __forceinline__ void rms_rows_bf16(const float* x, const float* g, bf16_t* out, int gw, int NGW, int lane) {
    f32x4 gv[8];
#pragma unroll
    for (int j = 0; j < 8; ++j) gv[j] = ((const f32x4*)g)[lane + 64 * j];
    f32x4 nx[8];
    if (gw < M) { const f32x4* xr = (const f32x4*)(x + (size_t)gw * DM) + lane;
#pragma unroll
        for (int j = 0; j < 8; ++j) nx[j] = xr[64 * j]; }
    for (int m = gw; m < M; m += NGW) {
        f32x4 v[8]; float s = 0.f;
#pragma unroll
        for (int j = 0; j < 8; ++j) v[j] = nx[j];
        if (m + NGW < M) { const f32x4* xr = (const f32x4*)(x + (size_t)(m + NGW) * DM) + lane;
#pragma unroll
            for (int j = 0; j < 8; ++j) nx[j] = xr[64 * j]; }
#pragma unroll
        for (int j = 0; j < 8; ++j) s += (v[j].x * v[j].x + v[j].y * v[j].y) + (v[j].z * v[j].z + v[j].w * v[j].w);
        const float rstd = __builtin_amdgcn_rsqf(wave_sum(s) * (1.f / DM) + EPS);
        v2u* o8 = (v2u*)(out + (size_t)m * DM) + lane;
#pragma unroll
        for (int j = 0; j < 8; ++j) { v2u w; w.x = pk2(v[j].x * rstd * gv[j].x, v[j].y * rstd * gv[j].y); w.y = pk2(v[j].z * rstd * gv[j].z, v[j].w * rstd * gv[j].w); o8[64 * j] = w; }
    }
}
__device__ __forceinline__ void rms_rows_f32(float* x, const float* g, int gw, int NGW, int lane) {
    f32x4 gv[8];
#pragma unroll
    for (int j = 0; j < 8; ++j) gv[j] = ((const f32x4*)g)[lane + 64 * j];
    f32x4 nx[8];
    if (gw < M) { const f32x4* xr = (const f32x4*)(x + (size_t)gw * DM) + lane;
#pragma unroll
        for (int j = 0; j < 8; ++j) nx[j] = xr[64 * j]; }
    for (int m = gw; m < M; m += NGW) {
        f32x4* xw = (f32x4*)(x + (size_t)m * DM) + lane; f32x4 v[8]; float s = 0.f;
#pragma unroll
        for (int j = 0; j < 8; ++j) v[j] = nx[j];
        if (m + NGW < M) { const f32x4* xr = (const f32x4*)(x + (size_t)(m + NGW) * DM) + lane;
#pragma unroll
            for (int j = 0; j < 8; ++j) nx[j] = xr[64 * j]; }
#pragma unroll
        for (int j = 0; j < 8; ++j) s += (v[j].x * v[j].x + v[j].y * v[j].y) + (v[j].z * v[j].z + v[j].w * v[j].w);
        const float rstd = __builtin_amdgcn_rsqf(wave_sum(s) * (1.f / DM) + EPS);
#pragma unroll
        for (int j = 0; j < 8; ++j) __builtin_nontemporal_store(v[j] * rstd * gv[j], xw + 64 * j);
    }
}
__device__ __forceinline__ void small_proj(const bf16_t* XN, const bf16_t* Wsm, float* PS, const float* rs, LAS unsigned char* lds, int wg, int G, int wid, int lane) {
    const int n16 = lane & 15, kq = lane >> 4; LAS f32x4* red = (LAS f32x4*)lds;
    for (int item = wg; item < M / 64; item += G) {
        const int rg = wid & 3, kh = wid >> 2, row = item * 64 + rg * 16 + n16;
        const bf16_t* ap = XN + (size_t)row * DM + kh * 1024 + kq * 8;
        const bf16_t* bp0 = Wsm + (size_t)n16 * DM + kh * 1024 + kq * 8; const bf16_t* bp1 = bp0 + (size_t)16 * DM;
        f32x4 a0 = {0.f, 0.f, 0.f, 0.f}, a1 = {0.f, 0.f, 0.f, 0.f};
#pragma unroll 8
        for (int ks = 0; ks < 32; ++ks) { const bf16x8 a = *(const bf16x8*)(ap + ks * 32), b0 = *(const bf16x8*)(bp0 + ks * 32), b1 = *(const bf16x8*)(bp1 + ks * 32);
            a0 = __builtin_amdgcn_mfma_f32_16x16x32_bf16(a, b0, a0, 0, 0, 0); a1 = __builtin_amdgcn_mfma_f32_16x16x32_bf16(a, b1, a1, 0, 0, 0); }
        if (kh == 1) { red[(rg * 2 + 0) * 64 + lane] = a0; red[(rg * 2 + 1) * 64 + lane] = a1; }
        __syncthreads();
        if (kh == 0) { a0 += red[(rg * 2 + 0) * 64 + lane]; a1 += red[(rg * 2 + 1) * 64 + lane];
#pragma unroll
            for (int r = 0; r < 4; ++r) { const int row = item * 64 + rg * 16 + 4 * kq + r; const float rstd = __builtin_amdgcn_rsqf(rs[row] * (1.0f / 2048.0f) + 1e-6f); float* pr = PS + (size_t)row * 32; pr[n16] = a0[r] * rstd; pr[16 + n16] = a1[r] * rstd; } }
        __syncthreads();
    }
}
__device__ __forceinline__ void fox_qk_norm(bf16_t* FQ, bf16_t* FK, const float* gq, const float* gk, int gw, int NGW, int lane) {
    const int d = (lane & 15) * 8; float gqv[8], gkv[8];
#pragma unroll
    for (int i = 0; i < 8; ++i) { gqv[i] = gq[d + i] * (0.08838834764831845f * 1.4426950408889634f); gkv[i] = gk[d + i]; }
    v4u nx[2][4];
    if (gw < M) {
#pragma unroll
        for (int j = 0; j < 4; ++j) { nx[0][j] = *((const v4u*)(FQ + (size_t)gw * DM + j * 512) + lane); nx[1][j] = *((const v4u*)(FK + (size_t)gw * DM + j * 512) + lane); } }
    for (int m = gw; m < M; m += NGW) {
        v4u cur[2][4];
#pragma unroll
        for (int w = 0; w < 2; ++w)
#pragma unroll
            for (int j = 0; j < 4; ++j) cur[w][j] = nx[w][j];
        if (m + NGW < M) {
#pragma unroll
            for (int j = 0; j < 4; ++j) { nx[0][j] = *((const v4u*)(FQ + (size_t)(m + NGW) * DM + j * 512) + lane); nx[1][j] = *((const v4u*)(FK + (size_t)(m + NGW) * DM + j * 512) + lane); } }
#pragma unroll
        for (int which = 0; which < 2; ++which) { bf16_t* rowp = (which ? FK : FQ) + (size_t)m * DM;
#pragma unroll
            for (int j = 0; j < 4; ++j) { v4u* p = (v4u*)(rowp + j * 512) + lane; const v4u w = cur[which][j]; float v[8] = {__uint_as_float(w.x << 16), __uint_as_float(w.x & 0xffff0000u), __uint_as_float(w.y << 16), __uint_as_float(w.y & 0xffff0000u),
                    __uint_as_float(w.z << 16), __uint_as_float(w.z & 0xffff0000u), __uint_as_float(w.w << 16), __uint_as_float(w.w & 0xffff0000u)};
                float s = 0.f;
#pragma unroll
                for (int i = 0; i < 8; ++i) s += v[i] * v[i];
                s += __shfl_xor(s, 1); s += __shfl_xor(s, 2); s += __shfl_xor(s, 4); s += __shfl_xor(s, 8);
                const float rstd = __builtin_amdgcn_rsqf(s * (1.f / 128.f) + EPS);
                v4u o;
                if (which == 0) { o.x = pk2(v[0] * rstd * gqv[0], v[1] * rstd * gqv[1]); o.y = pk2(v[2] * rstd * gqv[2], v[3] * rstd * gqv[3]); o.z = pk2(v[4] * rstd * gqv[4], v[5] * rstd * gqv[5]); o.w = pk2(v[6] * rstd * gqv[6], v[7] * rstd * gqv[7]); }
                else { o.x = pk2(v[0] * rstd * gkv[0], v[1] * rstd * gkv[1]); o.y = pk2(v[2] * rstd * gkv[2], v[3] * rstd * gkv[3]); o.z = pk2(v[4] * rstd * gkv[4], v[5] * rstd * gkv[5]); o.w = pk2(v[6] * rstd * gkv[6], v[7] * rstd * gkv[7]); }
                *p = o; } }
    }
}
__device__ __forceinline__ void fox_cumsum(const float* PS, const float* b_f, float* NB, int bh, LAS unsigned char* lds, int wid, int lane) {
    const int b = bh >> 4, h = bh & 15; const float bf = b_f[h]; LAS float* tot = (LAS float*)lds;
    const int t0 = wid * 1024 + lane * 16;
    const float* src = PS + ((size_t)b * T + t0) * 32 + 16 + h;
    float ls[16]; float s = 0.f;
#pragma unroll
    for (int i = 0; i < 16; ++i) { ls[i] = logsig(src[(size_t)i * 32] + bf); s += ls[i]; }
    float incl = s;
#pragma unroll
    for (int o = 1; o < 64; o <<= 1) { const float t = __shfl_up(incl, o); if (lane >= o) incl += t; }
    if (lane == 63) tot[wid] = incl;
    __syncthreads();
    float run = incl - s;
#pragma unroll
    for (int w = 0; w < 8; ++w) if (w < wid) run += tot[w];
    float* dst = NB + (size_t)bh * T + t0;
#pragma unroll
    for (int q = 0; q < 4; ++q) { f32x4 o;
#pragma unroll
        for (int i = 0; i < 4; ++i) { run += ls[4 * q + i]; o[i] = -run * 1.4426950408889634f; }
        *(f32x4*)(dst + 4 * q) = o; }
    __syncthreads();
}
__device__ __forceinline__ void gla_prep_item(int item, const float* PS, const float* w_up, const float* b_a, const bf16_t* GK, bf16_t* KT, float* ACH, LAS unsigned char* lds, int tid) {
    const int h = item & 3, c = (item >> 2) & 127, b = item >> 9; const int col = tid & 255, half = tid >> 8;
    LAS float* alr_s = (LAS float*)lds; LAS float* tot_s = alr_s + 64 * 16;
    const size_t row0 = (size_t)b * T + (size_t)c * 64;
#pragma unroll
    for (int i = 0; i < 2; ++i) { const int e = tid + 512 * i; alr_s[e] = PS[(row0 + (e >> 4)) * 32 + (e & 15)]; }
    float w[16];
#pragma unroll
    for (int j = 0; j < 16; ++j) w[j] = w_up[j * 1024 + h * 256 + col];
    const float ba = b_a[h * 256 + col];
    __syncthreads();
    float Gv[32]; float run = 0.f;
#pragma unroll
    for (int r = 0; r < 32; ++r) { const LAS f32x4* ar = (const LAS f32x4*)(alr_s + (half * 32 + r) * 16); float z = ba;
#pragma unroll
        for (int q = 0; q < 4; ++q) { const f32x4 a = ar[q]; z += a.x * w[4 * q] + a.y * w[4 * q + 1] + a.z * w[4 * q + 2] + a.w * w[4 * q + 3]; }
        run += logsig(z) * (1.0f / 16.0f); Gv[r] = run; }
    tot_s[half * 256 + col] = run;
    __syncthreads();
    const float t0 = tot_s[col], t1 = tot_s[256 + col], Gend = t0 + t1, off = half ? t0 : 0.f;
    const bf16_t* kp = GK + (row0 + half * 32) * 1024 + h * 256 + col;
    unsigned pk[16];
#pragma unroll
    for (int r = 0; r < 32; r += 2) { const float k0 = bfu(kp[(size_t)r * 1024]) * __expf(Gend - (Gv[r] + off)), k1 = bfu(kp[(size_t)(r + 1) * 1024]) * __expf(Gend - (Gv[r + 1] + off)); pk[r >> 1] = pk2(k0, k1); }
    v4u* dst = (v4u*)(KT + ((((size_t)b * NCH + c) * 4 + h) * 256 + col) * 64 + half * 32);
#pragma unroll
    for (int q = 0; q < 4; ++q) dst[q] = (v4u){pk[4 * q], pk[4 * q + 1], pk[4 * q + 2], pk[4 * q + 3]};
    if (half == 0) ACH[((size_t)b * NCH + c) * 1024 + h * 256 + col] = __expf(Gend);
    __syncthreads();
}
constexpr int GL_K = 0, GL_Q = 32768, GL_A = 65536, GL_BUF = 66560, GL_X = 2 * GL_BUF, GL_END = GL_X + 16384;
__device__ __forceinline__ void gla_scan(int unit, const bf16_t* KT, const bf16_t* GQ, bf16_t* GV, const float* ACH, float* OSQ, LAS unsigned char* lds, int tid, int wid, int lane) {
    const int slab = unit & 7, h = (unit >> 3) & 3, b = unit >> 5; const int n16 = lane & 15, q4 = lane >> 4, dvg = wid & 3, dkh = wid >> 2;
    f32x4 S[8];
#pragma unroll
    for (int i = 0; i < 8; ++i) S[i] = (f32x4){0.f, 0.f, 0.f, 0.f};
    v4u rk[4], rq[4], ra; unsigned short rv[16];
    const size_t vcol = (size_t)h * 512 + slab * 64 + dvg * 16 + n16;
#define GL_LOAD(c) do { const bf16_t* kt = KT + (((size_t)b * NCH + (c)) * 4 + h) * 256 * 64; const bf16_t* qc = GQ + ((size_t)b * T + (size_t)(c) * 64) * 1024 + h * 256; \
        _Pragma("unroll") for (int i = 0; i < 4; ++i) { const int p = tid + 512 * i; rk[i] = *(const v4u*)(kt + (size_t)p * 8); rq[i] = *(const v4u*)(qc + (size_t)(p >> 5) * 1024 + (p & 31) * 8); } \
        if (tid < 64) ra = *(const v4u*)(ACH + ((size_t)b * NCH + (c)) * 1024 + h * 256 + tid * 4); \
        const bf16_t* vc = GV + ((size_t)b * T + (size_t)(c) * 64) * 2048 + vcol; \
        _Pragma("unroll") for (int i = 0; i < 16; ++i) rv[i] = vc[(size_t)((i >> 3) * 32 + 8 * q4 + (i & 7)) * 2048]; } while (0)
#define GL_STORE(buf) do { LAS unsigned char* bb = lds + (buf) * GL_BUF; \
        _Pragma("unroll") for (int i = 0; i < 4; ++i) { const int p = tid + 512 * i; *(LAS v4u*)(bb + GL_K + (p >> 3) * 128 + (((p & 7) ^ ((p >> 3) & 7)) * 16)) = rk[i]; *(LAS v4u*)(bb + GL_Q + (p >> 5) * 512 + (((p & 31) ^ ((p >> 5) & 15)) * 16)) = rq[i]; } \
        if (tid < 64) *(LAS v4u*)(bb + GL_A + tid * 16) = ra; } while (0)
    GL_LOAD(0); GL_STORE(0);
    __syncthreads();
    for (int c = 0; c < NCH; ++c) {
        const int buf = c & 1; LAS unsigned char* bb = lds + buf * GL_BUF;
        bf16x8 vf[2];
#pragma unroll
        for (int ks = 0; ks < 2; ++ks) { v4u w; w.x = rv[8 * ks] | ((unsigned)rv[8 * ks + 1] << 16); w.y = rv[8 * ks + 2] | ((unsigned)rv[8 * ks + 3] << 16); w.z = rv[8 * ks + 4] | ((unsigned)rv[8 * ks + 5] << 16); w.w = rv[8 * ks + 6] | ((unsigned)rv[8 * ks + 7] << 16); vf[ks] = __builtin_bit_cast(bf16x8, w); }
        if (c + 1 < NCH) GL_LOAD(c + 1);
#pragma unroll
        for (int i = 0; i < 8; ++i) { const int row = dkh * 128 + 16 * i + n16; const f32x4 av = *(const LAS f32x4*)(bb + GL_A + (dkh * 128 + 16 * i + 4 * q4) * 4); S[i] = S[i] * av;
#pragma unroll
            for (int ks = 0; ks < 2; ++ks) { const bf16x8 a = *(const LAS bf16x8*)(bb + GL_K + row * 128 + (((4 * ks + q4) ^ (n16 & 7)) * 16));
                S[i] = __builtin_amdgcn_mfma_f32_16x16x32_bf16(a, vf[ks], S[i], 0, 0, 0); } }
        f32x4 o[4];
#pragma unroll
        for (int ct = 0; ct < 4; ++ct) o[ct] = (f32x4){0.f, 0.f, 0.f, 0.f};
#pragma unroll
        for (int j = 0; j < 4; ++j) { v4u bw; bw.x = pg8::cvt_pk_bf16(S[2 * j][0], S[2 * j][1]); bw.y = pg8::cvt_pk_bf16(S[2 * j][2], S[2 * j][3]); bw.z = pg8::cvt_pk_bf16(S[2 * j + 1][0], S[2 * j + 1][1]); bw.w = pg8::cvt_pk_bf16(S[2 * j + 1][2], S[2 * j + 1][3]);
            const bf16x8 bfr = __builtin_bit_cast(bf16x8, bw);
#pragma unroll
            for (int ct = 0; ct < 4; ++ct) { const LAS unsigned char* qrow = bb + GL_Q + (16 * ct + n16) * 512;
                const int e0 = dkh * 32 + 8 * j + q4; const v2u lo = *(const LAS v2u*)(qrow + ((e0 ^ (n16 << 1)) * 8)), hi = *(const LAS v2u*)(qrow + (((e0 + 4) ^ (n16 << 1)) * 8)); const v4u aw = {lo.x, lo.y, hi.x, hi.y};
                o[ct] = __builtin_amdgcn_mfma_f32_16x16x32_bf16(__builtin_bit_cast(bf16x8, aw), bfr, o[ct], 0, 0, 0); } }
        LAS f32x4* xch = (LAS f32x4*)(lds + GL_X);
        if (dkh == 0) { xch[((dvg * 2 + 0) * 2 + 0) * 64 + lane] = o[2]; xch[((dvg * 2 + 0) * 2 + 1) * 64 + lane] = o[3]; }
        else          { xch[((dvg * 2 + 1) * 2 + 0) * 64 + lane] = o[0]; xch[((dvg * 2 + 1) * 2 + 1) * 64 + lane] = o[1]; }
        __syncthreads();
#pragma unroll
        for (int t = 0; t < 2; ++t) { const int ct = 2 * dkh + t; const f32x4 mine = dkh == 0 ? o[t] : o[2 + t]; const f32x4 s = mine + xch[((dvg * 2 + (1 - dkh)) * 2 + t) * 64 + lane];
            bf16_t* oc = GV + ((size_t)b * T + (size_t)c * 64 + 16 * ct + 4 * q4) * 2048 + vcol;
            float* osqp = OSQ + ((size_t)b * T + (size_t)c * 64 + 16 * ct + 4 * q4) * 128 + h * 32 + slab * 4 + dvg;
#pragma unroll
            for (int r = 0; r < 4; ++r) { const float v = s[r] * 0.0625f; float sq = v * v;
                sq += __shfl_xor(sq, 1); sq += __shfl_xor(sq, 2); sq += __shfl_xor(sq, 4); sq += __shfl_xor(sq, 8);
                if (n16 == 0) osqp[(size_t)r * 128] = sq;
                oc[(size_t)r * 2048] = (bf16_t)f2bf(v); } }
        if (c + 1 < NCH) GL_STORE(buf ^ 1);
        __syncthreads();
    }
#undef GL_LOAD
#undef GL_STORE
}

#define XB_TMO      128
#define XB_XCNT(j)  (256  + 64 * (j))
#define XB_XSUB(j)  (1280 + 64 * (j))
#define XB_XGEN(j)  (2304 + 64 * (j))
#define XB_TOP      3328
#define XB_TOPGEN   3392
#define XCD_BAR_WORDS 3456
#define XB_SPIN_CAP (1u << 18)

__device__ __forceinline__ unsigned xb_ld(unsigned* p)              { return __hip_atomic_load(p, __ATOMIC_RELAXED, __HIP_MEMORY_SCOPE_AGENT); }
__device__ __forceinline__ unsigned xb_add(unsigned* p, unsigned v) { return __hip_atomic_fetch_add(p, v, __ATOMIC_RELAXED, __HIP_MEMORY_SCOPE_AGENT); }
__device__ __forceinline__ unsigned xb_xcc_id() { return (unsigned)__builtin_amdgcn_s_getreg((3 << 11) | 20) & 0xFu; }
#define XB_SPIN(cond, bar) do { unsigned _sp = 0; while (cond) { __builtin_amdgcn_s_sleep(1); \
    if ((++_sp & 255u) == 0u) { if (xb_ld(&(bar)[XB_TMO])) break; if (_sp > XB_SPIN_CAP) { atomicAdd(&(bar)[XB_TMO], 1u); break; } } } } while (0)

struct XcdBarrier {
    unsigned* bar; unsigned x;
    volatile LAS unsigned* st;
};

__device__ __forceinline__ XcdBarrier xcd_barrier_post(unsigned* bar, volatile LAS unsigned* st) {
    XcdBarrier b; b.bar = bar; b.x = xb_xcc_id(); b.st = st;
    if (threadIdx.x == 0) (void)xb_add(&bar[XB_XCNT(b.x)], 1u);
    return b;
}
__device__ __forceinline__ void xcd_barrier_complete(unsigned* bar, unsigned x, unsigned& nloc, unsigned& nx) {
    const unsigned G = gridDim.x * gridDim.y * gridDim.z;
    unsigned sum, cnt, mine, sp = 0u;
    for (;;) {
        sum = 0u; cnt = 0u; mine = 0u;
#pragma unroll
        for (unsigned j = 0; j < 16; ++j) { const unsigned c = xb_ld(&bar[XB_XCNT(j)]); sum += c; cnt += (c > 0u) ? 1u : 0u; mine = (j == x) ? c : mine; }
        if (sum == G) break;
        __builtin_amdgcn_s_sleep(1);
        if ((++sp & 255u) == 0u) { if (xb_ld(&bar[XB_TMO])) break; if (sp > XB_SPIN_CAP) { atomicAdd(&bar[XB_TMO], 1u); break; } }
    }
    nloc = mine > 0u ? mine : 1u; nx = cnt > 0u ? cnt : 1u;
}

__device__ __forceinline__ void xcd_barrier(const XcdBarrier& b) {
    asm volatile("s_waitcnt vmcnt(0)" ::: "memory");
    __syncthreads();
    if (threadIdx.x == 0) {
        unsigned* bar = b.bar;
        __builtin_amdgcn_s_waitcnt(0);
        unsigned nloc = b.st[0], nx = b.st[1];
        if (nloc == 0u) { xcd_barrier_complete(bar, b.x, nloc, nx); b.st[0] = nloc; b.st[1] = nx; }
        const unsigned old = xb_add(&bar[XB_XSUB(b.x)], 1u);
        const unsigned gen = old / nloc;
        if (old + 1u == (gen + 1u) * nloc) {
            __builtin_amdgcn_fence(__ATOMIC_RELEASE, "agent");
            asm volatile("s_waitcnt vmcnt(0)" ::: "memory");
            const unsigned og = xb_add(&bar[XB_TOP], 1u);
            const unsigned tg = og / nx;
            if (og + 1u == (tg + 1u) * nx) xb_add(&bar[XB_TOPGEN], 1u);
            else XB_SPIN(xb_ld(&bar[XB_TOPGEN]) == tg, bar);
            __builtin_amdgcn_fence(__ATOMIC_ACQUIRE, "agent");
            xb_add(&bar[XB_XGEN(b.x)], 1u);
            asm volatile("s_waitcnt vmcnt(0)" ::: "memory");
        } else {
            XB_SPIN(xb_ld(&bar[XB_XGEN(b.x)]) == gen, bar);
            __builtin_amdgcn_fence(__ATOMIC_ACQUIRE, "agent");
            asm volatile("s_waitcnt vmcnt(0)" ::: "memory");
        }
    }
    __syncthreads();
}

constexpr int CW_BAR = 4096;
constexpr int LDS_MISC = LDS_BYTES - 64;
#ifndef PHMASK
#define PHMASK 0x3fff
#endif
struct Args { const float* in[20]; float* out; unsigned char* ws; int ph_lo, ph_hi; };
constexpr int N_PHASES = 14;
constexpr int N_GLA_UNITS = 64, N_ATT_ITEMS = 1024;

#define GP(T, p) ((T*)(__attribute__((address_space(1))) T*)(p))
#define PH_BEGIN \
        int tidp_ = threadIdx.x; asm volatile("" : "+v"(tidp_)); \
        const int tid = tidp_, lane = tid & 63, wid = __builtin_amdgcn_readfirstlane(tid >> 6); \
        const int G = gridDim.x, wg = blockIdx.x, gw = wg * NWAVES + wid, NGW = G * NWAVES; \
        __attribute__((address_space(1))) unsigned char* ws_ = (__attribute__((address_space(1))) unsigned char*)args.ws; asm volatile("" : "+s"(ws_)); unsigned char* ws = (unsigned char*)ws_; \
        float* out = GP(float, args.out); \
        bf16_t* XN = (bf16_t*)(ws + WS_XN); bf16_t* WA = (bf16_t*)(ws + WS_WA); bf16_t* H = (bf16_t*)(ws + WS_H); \
        bf16_t* Wbrg = (bf16_t*)(ws + WS_WB); bf16_t* Wbrf = Wbrg + (size_t)2048 * 2048; bf16_t* Wout2 = Wbrf + (size_t)2048 * 2048; \
        bf16_t *GQ = (bf16_t*)(ws + WS_GQ), *GK = (bf16_t*)(ws + WS_GK), *GV = (bf16_t*)(ws + WS_GV), *FQ = (bf16_t*)(ws + WS_FQ), *FK = (bf16_t*)(ws + WS_FK), *FV = (bf16_t*)(ws + WS_FV); \
        bf16_t *KT = (bf16_t*)(ws + WS_KT), *SG = (bf16_t*)(ws + WS_SG), *SF = (bf16_t*)(ws + WS_SF), *MGF = (bf16_t*)(ws + WS_MGF); \
        float *PS = (float*)(ws + WS_PS), *ACH = (float*)(ws + WS_ACH), *NB = (float*)(ws + WS_NB), *OSQ = (float*)(ws + WS_OSQ); \
        unsigned* ctl = (unsigned*)(ws + WS_CTL); float* RS1 = (float*)(ws + WS_RS); float* RS2 = RS1 + M; (void)RS1; (void)RS2; \
        LAS float* scr = (LAS float*)(lds + wid * 16640); \
        (void)lane; (void)gw; (void)NGW; (void)out; (void)XN; (void)WA; (void)H; (void)Wbrg; (void)Wbrf; (void)Wout2; (void)GQ; (void)GK; (void)GV; (void)FQ; (void)FK; (void)FV; (void)KT; (void)SG; (void)SF; (void)MGF; (void)PS; (void)ACH; (void)NB; (void)OSQ; (void)ctl; (void)scr;
#define IN(k) ((((PHMASK) >> (k)) & 1) && lo <= (k) && (k) < hi)
#define SEAM(k) do { if (lo <= (k) && (k) + 1 < hi) { if ((k) == 0) { __syncthreads(); grid.sync(); } else { xcd_barrier(xbar); } } } while (0)
#define GEMM_UP(rs_) do { pg8::Gemm g{XN, WA, M, 2 * DFF, DM}; pg8::StaticOrder S; S.init(M, 2 * DFF, G, wg); pg8::EpiSwiGLU E{H, DFF, rs_}; \
        pg8::gemm_phase<pg8::EpiSwiGLU, pg8::StaticOrder, true, true>(lds, g, S, E, tid); } while (0)
#define GEMM_RES(BASE_BF, OUT_BF, A_, B_, K_, base_, out_, scale_, rs_) do { pg8::Gemm g{A_, B_, M, DM, K_}; pg8::StaticOrder S; S.init(M, DM, G, wg, 4); pg8::EpiResid<BASE_BF, OUT_BF> E{(const void*)(base_), (void*)(out_), scale_, rs_}; \
        pg8::gemm_phase<pg8::EpiResid<BASE_BF, OUT_BF>, pg8::StaticOrder, true, true>(lds, g, S, E, tid); } while (0)

__global__ void __launch_bounds__(NWAVES * 64, 2) fwd_mega(Args args) {
    extern __shared__ __attribute__((aligned(16))) unsigned char lds_raw[];
    LAS unsigned char* lds = (LAS unsigned char*)lds_raw;
    cg::grid_group grid = cg::this_grid();
    const int lo = args.ph_lo, hi = args.ph_hi;
    { volatile LAS unsigned* misc = (volatile LAS unsigned*)(lds + LDS_MISC); if (threadIdx.x < 2) misc[threadIdx.x] = 0u; }
    __syncthreads();
    const XcdBarrier xbar = xcd_barrier_post((unsigned*)(GP(unsigned char, args.ws) + WS_CTL) + CW_BAR, (volatile LAS unsigned*)(lds + LDS_MISC));
    if (IN(0)) { PH_BEGIN
        int base = 0;
        if (wg == 0 && tid == 0) ctl[0] = 0u;
        for (int i = wg * 512 + tid; i < 2 * M; i += G * 512) RS1[i] = 0.f;
        conv_range(GP(const float, args.in[2]), DM, 2 * DFF, WA, DM, 2 * DFF, CM_SWIGLU, (const float*)nullptr, base, gw, NGW, scr, lane);
        conv_range(GP(const float, args.in[3]), DFF, DM, WA + (size_t)2 * DFF * DM, DFF, DM, CM_ID, (const float*)nullptr, base, gw, NGW, scr, lane);
        conv_range(GP(const float, args.in[12]), DM, DM, Wbrg, DM, DM, CM_ID, (const float*)nullptr, base, gw, NGW, scr, lane);
        conv_range(GP(const float, args.in[13]), DM, DM, Wbrf, DM, DM, CM_ID, (const float*)nullptr, base, gw, NGW, scr, lane);
        conv_range(GP(const float, args.in[15]), DM, DM, Wout2, DM, DM, CM_ID, (const float*)nullptr, base, gw, NGW, scr, lane);
        rms_rows_bf16(GP(const float, args.in[0]), GP(const float, args.in[1]), XN, gw, NGW, lane);
    }
    SEAM(0);
    if (IN(1)) { PH_BEGIN GEMM_UP((const float*)nullptr); }
    SEAM(1);
    if (IN(2)) { PH_BEGIN GEMM_RES(false, true, H, WA + (size_t)2 * DFF * DM, DFF, GP(const float, args.in[0]), XN, 0.5f, RS1); }
    SEAM(2);
    if (IN(3)) { PH_BEGIN
        int base = 0;
        conv_range(GP(const float, args.in[5]), DM, IN_W, WA, DM, IN_W, CM_WIN, GP(const float, args.in[4]), base, gw, NGW, scr, lane);
    }
    SEAM(3);
    if (IN(4)) {
        { PH_BEGIN small_proj(XN, WA + (size_t)18432 * DM, PS, RS1, lds, wg, G, wid, lane); }
        { PH_BEGIN
          pg8::Gemm g{XN, WA, M, 10240, DM}; pg8::StaticOrder S; S.init(M, 10240, G, wg);
          pg8::EpiQKV E{GQ, GK, GV, FQ, FK, FV, RS1};
          pg8::gemm_phase<pg8::EpiQKV, pg8::StaticOrder, true, true>(lds, g, S, E, tid); }
    }
    SEAM(4);
    if (IN(5)) { PH_BEGIN
        for (int item = wg; item < 2 * NCH * 4; item += G) gla_prep_item(item, PS, GP(const float, args.in[6]), GP(const float, args.in[7]), GK, KT, ACH, lds, tid);
        if (wg >= G - 32) fox_cumsum(PS, GP(const float, args.in[9]), NB, wg - (G - 32), lds, wid, lane);
        fox_qk_norm(FQ, FK, GP(const float, args.in[10]), GP(const float, args.in[11]), gw, NGW, lane);
    }
    SEAM(5);
    if (IN(6)) {
        if (blockIdx.x < N_GLA_UNITS) { PH_BEGIN gla_scan(wg, KT, GQ, GV, ACH, OSQ, lds, tid, wid, lane); __syncthreads(); }
        { PH_BEGIN
            LAS volatile int* nxt_s = (LAS volatile int*)(lds + fox::LDS_BYTES);
#define FOX_REF(i) ({ const int qb_ = 31 - ((i) >> 5), bh_ = (i) & 31; fox::BlockRef r_; r_.ro = (unsigned)(bh_ >> 4) * (unsigned)(T * DM) + (unsigned)(bh_ & 15) * 128u; r_.bh = bh_; r_.P0 = qb_ * 256; r_; })
            if (tid == 0) nxt_s[0] = (int)atomicAdd(ctl, 1u);
            __syncthreads();
            int cur_i = __builtin_amdgcn_readfirstlane(nxt_s[0]);
            if (cur_i < N_ATT_ITEMS) {
                const fox::Bases Bs{(fox::bf16*)FQ, (const fox::bf16*)FK, (const fox::bf16*)FV, NB};
                fox::BlockRef cur = FOX_REF(cur_i);
                fox::Seam Sm;
                fox::prime(Bs, cur, (char*)lds_raw, Sm, tid);
                for (;;) {
                    if (tid == 0) nxt_s[1] = (int)atomicAdd(ctl, 1u);
                    __syncthreads();
                    const int nxt_i = __builtin_amdgcn_readfirstlane(nxt_s[1]);
                    const fox::BlockRef nxt = nxt_i < N_ATT_ITEMS ? FOX_REF(nxt_i) : cur;
                    fox::block(Bs, cur, nxt, (char*)lds_raw, Sm, tid);
                    if (nxt_i >= N_ATT_ITEMS) break;
                    cur = nxt;
                }
            }
#undef FOX_REF
        }
    }
    SEAM(6);
    if (IN(7)) { PH_BEGIN
        pg8::Gemm g{XN, WA + (size_t)10240 * DM, M, 8192, DM}; pg8::StaticOrder S; S.init(M, 8192, G, wg);
        pg8::EpiGates E{GV, FQ, SG, SF, OSQ, GP(const float, args.in[8]), GP(const float, args.in[14]), RS1};
        pg8::gemm_phase<pg8::EpiGates, pg8::StaticOrder, true, true>(lds, g, S, E, tid);
    }
    SEAM(7);
    if (IN(8)) {
        { PH_BEGIN int base = 0;
          conv_range(GP(const float, args.in[17]), DM, 2 * DFF, WA, DM, 2 * DFF, CM_SWIGLU, GP(const float, args.in[16]), base, gw, NGW, scr, lane);
          conv_range(GP(const float, args.in[18]), DFF, DM, WA + (size_t)2 * DFF * DM, DFF, DM, CM_ID, (const float*)nullptr, base, gw, NGW, scr, lane);
          __syncthreads(); }
        { PH_BEGIN
          pg8::Gemm g{FQ, Wbrg, 2 * M, 2 * DM, DM};
          pg8::PairOrder S; S.init(M, DM, G, wg, 4);
          pg8::EpiGated E{SG, SF, MGF};
          pg8::gemm_phase<pg8::EpiGated, pg8::PairOrder, true, true>(lds, g, S, E, tid); }
    }
    SEAM(8);
    if (IN(9)) { PH_BEGIN GEMM_RES(true, true, MGF, Wout2, DM, XN, XN, 1.0f, RS2); }
    SEAM(9);
    if (IN(11)) { PH_BEGIN GEMM_UP((const float*)RS2); }
    SEAM(11);
    if (IN(12)) { PH_BEGIN GEMM_RES(true, false, H, WA + (size_t)2 * DFF * DM, DFF, XN, out, 0.5f, (float*)nullptr); }
    SEAM(12);
    if (IN(13)) { PH_BEGIN rms_rows_f32(out, GP(const float, args.in[19]), gw, NGW, lane); }
}

extern "C" void kernel_launch(void* const* d_in, const int* in_sizes, int n_in, void* d_out, int out_size, void* d_ws, size_t ws_size, hipStream_t stream) {
    static int grid = 0;
    if (grid == 0) {
        if (n_in != 20 || out_size != M * DM || ws_size < WS_END) { fprintf(stderr, "kernel_launch: unexpected shapes (n_in %d out %d ws %zu)\n", n_in, out_size, ws_size); grid = -1; return; }
        int dev = 0, cus = 0;
        (void)hipGetDevice(&dev); (void)hipDeviceGetAttribute(&cus, hipDeviceAttributeMultiprocessorCount, dev);
        (void)hipFuncSetAttribute((const void*)fwd_mega, hipFuncAttributeMaxDynamicSharedMemorySize, LDS_BYTES);
        int per_cu = 0;
        (void)hipOccupancyMaxActiveBlocksPerMultiprocessor(&per_cu, (const void*)fwd_mega, NWAVES * 64, LDS_BYTES);
        if (per_cu < 1) fprintf(stderr, "kernel_launch: occupancy query says %d blocks per CU\n", per_cu);
        (void)hipGetLastError();
        grid = cus > 0 ? cus : 256;
    }
    if (grid < 0) return;
    if (hipMemsetAsync((char*)d_ws + WS_CTL, 0, 65536, stream) != hipSuccess) { fprintf(stderr, "kernel_launch: memset of the control words failed\n"); return; }
    Args a{};
    for (int i = 0; i < 20; ++i) a.in[i] = (const float*)d_in[i];
    a.out = (float*)d_out; a.ws = (unsigned char*)d_ws;
#if MK_MULTI
    for (int ph = 0; ph < N_PHASES; ++ph) { a.ph_lo = ph; a.ph_hi = ph + 1; hipLaunchKernelGGL(fwd_mega, dim3(grid), dim3(NWAVES * 64), LDS_BYTES, stream, a); }
#else
    a.ph_lo = 0; a.ph_hi = N_PHASES;
    void* kargs[] = {&a};
    hipError_t e = hipLaunchCooperativeKernel((const void*)fwd_mega, dim3(grid), dim3(NWAVES * 64), kargs, LDS_BYTES, stream);
    if (e != hipSuccess) fprintf(stderr, "cooperative launch failed: %s (grid %d)\n", hipGetErrorString(e), grid);
#endif
}
```

```cpp
#include <hip/hip_runtime.h>
#include <hip/hip_bf16.h>
#include <hip/hip_cooperative_groups.h>
#include <cstdio>
#include <cstdint>
#ifndef MK_MULTI
#define MK_MULTI 0
#endif
namespace cg = cooperative_groups;
namespace pg8 {
#define PG8_LAS __attribute__((address_space(3)))
typedef unsigned short bf16_t;
typedef short bf16x8 __attribute__((ext_vector_type(8)));
typedef float f32x4 __attribute__((ext_vector_type(4)));
typedef unsigned u32x4 __attribute__((ext_vector_type(4)));
constexpr int BM = 256, BK = 64, HALF = 128, HTB = HALF * BK * 2  , STAGE_BYTES = 8 * HTB, NXCD = 8, WGM = 8;

__host__ __device__ __forceinline__ int lds_byte(int r, int c) { const int st = (r >> 4) * 2 + (c >> 5), rr = r & 15, cc = c & 31, ob = rr * 64 + cc * 2; return st * 1024 + (ob ^ (((ob >> 9) & 1) << 5)); }
__host__ __device__ __forceinline__ void stage_rc(int b, int& R, int& C) { const int st = b / 1024, sb = b % 1024, swz = sb ^ (((sb >> 9) & 1) << 5); R = (st >> 1) * 16 + swz / 64; C = (st & 1) * 32 + (swz % 64) / 2; }
__host__ __device__ __forceinline__ int perm32(int rho) { const int n = rho >> 4, i = rho & 15; return 8 * (i >> 2) + 4 * n + (i & 3); }

struct Unit { int pm, pn; };
struct Gemm { const bf16_t* A; const bf16_t* Bt; int M, N, K; };

struct StaticOrder {
    int nM, nN, nwg, G, c, wgm;
    __host__ __device__ void init(int M, int N, int G_, int c_, int wgm_ = WGM) { nM = M / BM; nN = N / BM; nwg = nM * nN; G = G_; c = c_; wgm = wgm_; }
    __host__ __device__ bool next(int i, Unit& u) const {
        const long L = (long)i * G + c; if (L >= nwg) return false;
        int wgid = (int)L; { const int q = nwg / NXCD, r = nwg % NXCD, xcd = wgid % NXCD, off = wgid / NXCD; wgid = (xcd < r ? xcd * (q + 1) : r * (q + 1) + (xcd - r) * q) + off; }
        const int nig = wgm * nN, gid = wgid / nig, fm = gid * wgm, gsz = (nM - fm) < wgm ? (nM - fm) : wgm;
        u.pm = fm + ((wgid % nig) % gsz); u.pn = (wgid % nig) / gsz; return true;
    }
    __device__ __forceinline__ void a_ready(const Unit&) const {}
    __device__ __forceinline__ void done(const Unit&) const {}
};

typedef float f32x2c_t __attribute__((ext_vector_type(2))); typedef __bf16 bf16x2c_t __attribute__((ext_vector_type(2)));
__device__ __forceinline__ unsigned cvt_pk_bf16(float lo, float hi) { const f32x2c_t v = {lo, hi}; const bf16x2c_t b = __builtin_convertvector(v, bf16x2c_t); return __builtin_bit_cast(unsigned, b); }
typedef float f32x2 __attribute__((ext_vector_type(2)));
__device__ __forceinline__ f32x2 gelu_pk(f32x2 v) {
    const f32x2 av = __builtin_elementwise_abs(v), d = av * 0.2316418882f + 1.0f;
    f32x2 t; t.x = __builtin_amdgcn_rcpf(d.x); t.y = __builtin_amdgcn_rcpf(d.y);
    f32x2 q = t * 0.5307027145f + (-0.7265760135f); q = q * t + 0.7107068705f; q = q * t + (-0.142248368f); q = q * t + 0.127414796f; q = q * t;
    const f32x2 s = (v * v) * (-0.72134752044f);
    f32x2 e; e.x = __builtin_amdgcn_exp2f(s.x); e.y = __builtin_amdgcn_exp2f(s.y);
    const f32x2 m = v * (q * e), r = v - m;
    f32x2 o; o.x = v.x < 0.f ? m.x : r.x; o.y = v.y < 0.f ? m.y : r.y; return o;
}

template <int ACT  > struct EpiBf16 {
    static constexpr bool PERM = true, AFTER_DRAIN = false; static_assert(ACT == 0 || ACT == 1, "EpiBf16: ACT is 0 (none) or 1 (gelu_pk)");
    bf16_t* O; int ldc; const float* bias; int split_cols; size_t split_stride; float scale0;
    __device__ __forceinline__ void operator()(const f32x4 (&acc)[2][2][4][2], const Unit& u, int wr, int wc, int fr, int fq) const {
        const int row0 = u.pm * BM + wr * 64 + fr; int colt = u.pn * BM; bf16_t* base = O;
        float sc = 1.f; if (split_cols) { const int t = colt / split_cols; base += (size_t)t * split_stride; colt -= t * split_cols; if (t == 0) sc = scale0; }
        const int col0 = colt + wc * 32 + 8 * fq, bcol0 = u.pn * BM + wc * 32 + 8 * fq;
        f32x4 bv[2][2];
#pragma unroll
        for (int bj = 0; bj < 2; ++bj)
#pragma unroll
            for (int n = 0; n < 2; ++n) bv[bj][n] = bias ? *(const f32x4*)(bias + bcol0 + bj * HALF + 4 * n) : (f32x4){0.f, 0.f, 0.f, 0.f};
#pragma unroll
        for (int ai = 0; ai < 2; ++ai)
#pragma unroll
            for (int m = 0; m < 4; ++m) { bf16_t* rowp = base + (size_t)(row0 + ai * HALF + m * 16) * ldc + col0;
#pragma unroll
                for (int bj = 0; bj < 2; ++bj) { f32x4 v0 = acc[ai][bj][m][0] + bv[bj][0], v1 = acc[ai][bj][m][1] + bv[bj][1];
                    if (ACT == 1) { f32x2 a = gelu_pk((f32x2){v0[0], v0[1]}), b = gelu_pk((f32x2){v0[2], v0[3]}), c = gelu_pk((f32x2){v1[0], v1[1]}), d = gelu_pk((f32x2){v1[2], v1[3]});
                        v0 = (f32x4){a.x, a.y, b.x, b.y}; v1 = (f32x4){c.x, c.y, d.x, d.y}; }
                    v0 = v0 * sc; v1 = v1 * sc; u32x4 w; w.x = cvt_pk_bf16(v0[0], v0[1]); w.y = cvt_pk_bf16(v0[2], v0[3]); w.z = cvt_pk_bf16(v1[0], v1[1]); w.w = cvt_pk_bf16(v1[2], v1[3]);
                    *(u32x4*)(rowp + bj * HALF) = w; } }
    }
};
__device__ __forceinline__ float sigmoid_f(float x) { return __builtin_amdgcn_rcpf(1.0f + __builtin_amdgcn_exp2f(-1.4426950408889634f * x)); }
__device__ __forceinline__ float silu_f(float x) { return x * sigmoid_f(x); }
__device__ __forceinline__ float bf_lo(unsigned w) { return __uint_as_float(w << 16); }
__device__ __forceinline__ float bf_hi(unsigned w) { return __uint_as_float(w & 0xffff0000u); }
typedef unsigned u32x2 __attribute__((ext_vector_type(2)));

struct EpiSwiGLU {
    static constexpr bool PERM = true, AFTER_DRAIN = false;
    bf16_t* H; int ldh; const float* rs;
    __device__ __forceinline__ void operator()(const f32x4 (&acc)[2][2][4][2], const Unit& u, int wr, int wc, int fr, int fq) const {
        const int row0 = u.pm * BM + wr * 64 + fr, col0 = u.pn * HALF + wc * 32 + 8 * fq;
#pragma unroll
        for (int ai = 0; ai < 2; ++ai)
#pragma unroll
            for (int m = 0; m < 4; ++m) {
                bf16_t* rowp = H + (size_t)(row0 + ai * HALF + m * 16) * ldh + col0;
                const float rstd = rs ? __builtin_amdgcn_rsqf(rs[row0 + ai * HALF + m * 16] * (1.0f / 2048.0f) + 1e-6f) : 1.0f;
                const f32x4 g0 = acc[ai][0][m][0] * rstd, g1 = acc[ai][0][m][1] * rstd, u0 = acc[ai][1][m][0] * rstd, u1 = acc[ai][1][m][1] * rstd;
                u32x4 w;
                w.x = cvt_pk_bf16(silu_f(g0[0]) * u0[0], silu_f(g0[1]) * u0[1]); w.y = cvt_pk_bf16(silu_f(g0[2]) * u0[2], silu_f(g0[3]) * u0[3]);
                w.z = cvt_pk_bf16(silu_f(g1[0]) * u1[0], silu_f(g1[1]) * u1[1]); w.w = cvt_pk_bf16(silu_f(g1[2]) * u1[2], silu_f(g1[3]) * u1[3]);
                *(u32x4*)rowp = w;
            }
    }
};
template <bool BASE_BF, bool OUT_BF> struct EpiResid {
    static constexpr bool PERM = true, AFTER_DRAIN = false;
    const void* base; void* out; float scale; float* rs;
    __device__ __forceinline__ void operator()(const f32x4 (&acc)[2][2][4][2], const Unit& u, int wr, int wc, int fr, int fq) const {
        const int row0 = u.pm * BM + wr * 64 + fr, col0 = u.pn * BM + wc * 32 + 8 * fq;
#pragma unroll
        for (int ai = 0; ai < 2; ++ai) {
            f32x4 bv[4][2][2];
#pragma unroll
            for (int m = 0; m < 4; ++m)
#pragma unroll
                for (int bj = 0; bj < 2; ++bj) { const size_t off = (size_t)(row0 + ai * HALF + m * 16) * 2048 + col0 + bj * HALF;
                    if (BASE_BF) { const u32x4 w = *(const u32x4*)((const bf16_t*)base + off); bv[m][bj][0] = (f32x4){bf_lo(w.x), bf_hi(w.x), bf_lo(w.y), bf_hi(w.y)}; bv[m][bj][1] = (f32x4){bf_lo(w.z), bf_hi(w.z), bf_lo(w.w), bf_hi(w.w)}; }
                    else { const float* bp = (const float*)base + off; bv[m][bj][0] = __builtin_nontemporal_load((const f32x4*)bp); bv[m][bj][1] = __builtin_nontemporal_load((const f32x4*)(bp + 4)); } }
            asm volatile("" ::: "memory");
#pragma unroll
            for (int m = 0; m < 4; ++m) { const int row = row0 + ai * HALF + m * 16; float ss = 0.f;
#pragma unroll
                for (int bj = 0; bj < 2; ++bj) { const size_t off = (size_t)row * 2048 + col0 + bj * HALF;
                    const f32x4 y0 = bv[m][bj][0] + acc[ai][bj][m][0] * scale, y1 = bv[m][bj][1] + acc[ai][bj][m][1] * scale;
                    ss += ((y0[0] * y0[0] + y0[1] * y0[1]) + (y0[2] * y0[2] + y0[3] * y0[3])) + ((y1[0] * y1[0] + y1[1] * y1[1]) + (y1[2] * y1[2] + y1[3] * y1[3]));
                    if (OUT_BF) { u32x4 w; w.x = cvt_pk_bf16(y0[0], y0[1]); w.y = cvt_pk_bf16(y0[2], y0[3]); w.z = cvt_pk_bf16(y1[0], y1[1]); w.w = cvt_pk_bf16(y1[2], y1[3]); *(u32x4*)((bf16_t*)out + off) = w; }
                    else { float* op = (float*)out + off; *(f32x4*)op = y0; *(f32x4*)(op + 4) = y1; } }
                if (rs) { ss += __shfl_xor(ss, 16); ss += __shfl_xor(ss, 32); if (fq == 0) atomicAdd(rs + row, ss); } }
            asm volatile("" ::: "memory"); }
    }
};
struct EpiQKV {
    static constexpr bool PERM = true, AFTER_DRAIN = false;
    bf16_t *gq, *gk, *gv, *fq_, *fk, *fv; const float* rs;
    __device__ __forceinline__ void operator()(const f32x4 (&acc)[2][2][4][2], const Unit& u, int wr, int wc, int fr, int fq) const {
        bf16_t* base; int ldc, colt; const int pn = u.pn;
        if (pn < 4) { base = gq; ldc = 1024; colt = pn * 256; } else if (pn < 8) { base = gk; ldc = 1024; colt = (pn - 4) * 256; }
        else if (pn < 16) { base = gv; ldc = 2048; colt = (pn - 8) * 256; } else if (pn < 24) { base = fq_; ldc = 2048; colt = (pn - 16) * 256; }
        else if (pn < 32) { base = fk; ldc = 2048; colt = (pn - 24) * 256; } else { base = fv; ldc = 2048; colt = (pn - 32) * 256; }
        const int row0 = u.pm * BM + wr * 64 + fr, col0 = colt + wc * 32 + 8 * fq;
#pragma unroll
        for (int ai = 0; ai < 2; ++ai)
#pragma unroll
            for (int m = 0; m < 4; ++m) { bf16_t* rowp = base + (size_t)(row0 + ai * HALF + m * 16) * ldc + col0;
                const float rstd = __builtin_amdgcn_rsqf(rs[row0 + ai * HALF + m * 16] * (1.0f / 2048.0f) + 1e-6f);
#pragma unroll
                for (int bj = 0; bj < 2; ++bj) { const f32x4 v0 = acc[ai][bj][m][0] * rstd, v1 = acc[ai][bj][m][1] * rstd;
                    u32x4 w; w.x = cvt_pk_bf16(v0[0], v0[1]); w.y = cvt_pk_bf16(v0[2], v0[3]); w.z = cvt_pk_bf16(v1[0], v1[1]); w.w = cvt_pk_bf16(v1[2], v1[3]);
                    *(u32x4*)(rowp + bj * HALF) = w; } }
    }
};
struct EpiGates {
    static constexpr bool PERM = true, AFTER_DRAIN = false;
    bf16_t *agla, *afox, *sg, *sf; const float* osq; const float* gon; const float* bm; const float* rsx;
    __device__ __forceinline__ void operator()(const f32x4 (&acc)[2][2][4][2], const Unit& u, int wr, int wc, int fr, int fq) const {
        const int pn = u.pn, kind = pn >> 3, colt = (pn & 7) * 256;
        const int row0 = u.pm * BM + wr * 64 + fr, col0 = colt + wc * 32 + 8 * fq;
        bf16_t* base = kind == 0 ? agla : kind == 1 ? afox : kind == 2 ? sg : sf;
        f32x4 cv[2][2];
#pragma unroll
        for (int bj = 0; bj < 2; ++bj)
#pragma unroll
            for (int n = 0; n < 2; ++n) {
                if (kind == 0) cv[bj][n] = *(const f32x4*)(gon + col0 + bj * HALF + 4 * n);
                else if (kind >= 2) cv[bj][n] = *(const f32x4*)(bm + (kind - 2) * 2048 + col0 + bj * HALF + 4 * n);
                else cv[bj][n] = (f32x4){0.f, 0.f, 0.f, 0.f}; }
#pragma unroll
        for (int ai = 0; ai < 2; ++ai) {
            u32x4 ov[4][2]; float rstd[4], rso[4];
#pragma unroll
            for (int m = 0; m < 4; ++m) { const int row = row0 + ai * HALF + m * 16; rstd[m] = rsx[row]; rso[m] = 1.f;
                if (kind == 0) { const f32x4* pp = (const f32x4*)(osq + (size_t)row * 128 + (pn >> 1) * 32 + fq * 8); const f32x4 p = pp[0] + pp[1]; rso[m] = (p[0] + p[1]) + (p[2] + p[3]); }
#pragma unroll
                for (int bj = 0; bj < 2; ++bj) ov[m][bj] = kind <= 1 ? *(const u32x4*)(base + (size_t)row * 2048 + col0 + bj * HALF) : (u32x4){0u, 0u, 0u, 0u}; }
            asm volatile("" ::: "memory");
#pragma unroll
            for (int m = 0; m < 4; ++m) { const int row = row0 + ai * HALF + m * 16; bf16_t* rowp = base + (size_t)row * 2048 + col0;
                const float rs_x = __builtin_amdgcn_rsqf(rstd[m] * (1.0f / 2048.0f) + 1e-6f); float rs = 1.f;
                if (kind == 0) { float t = rso[m]; t += __shfl_xor(t, 16); t += __shfl_xor(t, 32); rs = __builtin_amdgcn_rsqf(t * (1.0f / 512.0f) + 1e-6f); }
#pragma unroll
                for (int bj = 0; bj < 2; ++bj) { const f32x4 v0 = acc[ai][bj][m][0] * rs_x, v1 = acc[ai][bj][m][1] * rs_x; float r[8];
                    if (kind <= 1) { const u32x4 o = ov[m][bj];
                        const float ovv[8] = {bf_lo(o.x), bf_hi(o.x), bf_lo(o.y), bf_hi(o.y), bf_lo(o.z), bf_hi(o.z), bf_lo(o.w), bf_hi(o.w)};
#pragma unroll
                        for (int i = 0; i < 4; ++i) {
                            if (kind == 0) { r[i] = ovv[i] * rs * cv[bj][0][i] * silu_f(v0[i]); r[4 + i] = ovv[4 + i] * rs * cv[bj][1][i] * silu_f(v1[i]); }
                            else { r[i] = ovv[i] * sigmoid_f(v0[i]); r[4 + i] = ovv[4 + i] * sigmoid_f(v1[i]); } }
                    } else {
#pragma unroll
                        for (int i = 0; i < 4; ++i) { r[i] = sigmoid_f(v0[i] + cv[bj][0][i]); r[4 + i] = sigmoid_f(v1[i] + cv[bj][1][i]); } }
                    u32x4 w; w.x = cvt_pk_bf16(r[0], r[1]); w.y = cvt_pk_bf16(r[2], r[3]); w.z = cvt_pk_bf16(r[4], r[5]); w.w = cvt_pk_bf16(r[6], r[7]);
                    *(u32x4*)(rowp + bj * HALF) = w; } }
            asm volatile("" ::: "memory"); }
    }
};
struct EpiGated {
    static constexpr bool PERM = true, AFTER_DRAIN = false;
    const bf16_t* sg; const bf16_t* sf; bf16_t* mg;
    __device__ __forceinline__ void operator()(const f32x4 (&acc)[2][2][4][2], const Unit& u, int wr, int wc, int fr, int fq) const {
        const bool fox = u.pn >= 8; const int pm = u.pm & 63, pn = u.pn & 7; const bf16_t* gate = fox ? sf : sg;
        const int row0 = pm * BM + wr * 64 + fr, col0 = pn * BM + wc * 32 + 8 * fq;
#pragma unroll
        for (int ai = 0; ai < 2; ++ai) {
            u32x4 gv[4][2], pv[4][2];
#pragma unroll
            for (int m = 0; m < 4; ++m)
#pragma unroll
                for (int bj = 0; bj < 2; ++bj) { const size_t off = (size_t)(row0 + ai * HALF + m * 16) * 2048 + col0 + bj * HALF;
                    gv[m][bj] = *(const u32x4*)(gate + off); pv[m][bj] = fox ? *(const u32x4*)(mg + off) : (u32x4){0u, 0u, 0u, 0u}; }
            asm volatile("" ::: "memory");
#pragma unroll
            for (int m = 0; m < 4; ++m)
#pragma unroll
                for (int bj = 0; bj < 2; ++bj) { const f32x4 v0 = acc[ai][bj][m][0], v1 = acc[ai][bj][m][1]; const size_t off = (size_t)(row0 + ai * HALF + m * 16) * 2048 + col0 + bj * HALF;
                    const u32x4 g = gv[m][bj], p = pv[m][bj];
                    float r[8] = {bf_lo(g.x) * v0[0], bf_hi(g.x) * v0[1], bf_lo(g.y) * v0[2], bf_hi(g.y) * v0[3], bf_lo(g.z) * v1[0], bf_hi(g.z) * v1[1], bf_lo(g.w) * v1[2], bf_hi(g.w) * v1[3]};
                    r[0] += bf_lo(p.x); r[1] += bf_hi(p.x); r[2] += bf_lo(p.y); r[3] += bf_hi(p.y); r[4] += bf_lo(p.z); r[5] += bf_hi(p.z); r[6] += bf_lo(p.w); r[7] += bf_hi(p.w);
                    u32x4 w; w.x = cvt_pk_bf16(r[0], r[1]); w.y = cvt_pk_bf16(r[2], r[3]); w.z = cvt_pk_bf16(r[4], r[5]); w.w = cvt_pk_bf16(r[6], r[7]);
                    *(u32x4*)(mg + off) = w; }
            asm volatile("" ::: "memory"); }
    }
};
struct PairOrder {
    StaticOrder so;
    __host__ __device__ void init(int M, int N, int G_, int c_, int wgm_) { so.init(M, N, G_, c_, wgm_); }
    __host__ __device__ bool next(int i, Unit& u) const { Unit b; if (!so.next(i >> 1, b)) return false; if (i & 1) { u.pm = b.pm; u.pn = b.pn + 8; } else { u.pm = b.pm + 64; u.pn = b.pn; } return true; }
    __device__ __forceinline__ void a_ready(const Unit&) const {}
    __device__ __forceinline__ void done(const Unit&) const {}
};
template <class Epi, class Sched, bool ALIGN_EPI = false, bool SP2 = false>
__device__ __forceinline__ void gemm_phase(PG8_LAS unsigned char* lds, const Gemm g, const Sched& S, const Epi& E, const int tid) {
    const int wid = __builtin_amdgcn_readfirstlane(tid >> 6), lane = tid & 63, wr = wid >> 2, wc = wid & 3, fr = lane & 15, fq = lane >> 4;
    const int K = g.K, nt = K / BK;
    unsigned voffA[2], voffB[2];
#pragma unroll
    for (int i = 0; i < 2; ++i) { int R, C; stage_rc(tid * 16 + i * 8192, R, C); const int Rb = Epi::PERM ? ((R & ~31) + perm32(R & 31)) : R;
        voffA[i] = (unsigned)(R * K + C) * 2u; voffB[i] = (unsigned)(Rb * K + C) * 2u; }
    const size_t kstep = (size_t)(BK * 2);
    const size_t hstep = (size_t)HALF * K * 2;
    const size_t tstep = 2 * hstep;
    const unsigned ldsw = (unsigned)wid * 1024u;
    const int aoff = lds_byte(wr * 64 + fr, fq * 8), boff = lds_byte(wc * 32 + fr, fq * 8);
#define PG8_SA(b, h) (((b) * 2 + (h)) * HTB)
#define PG8_SB(b, h) ((4 + (b) * 2 + (h)) * HTB)
#define PG8_STAGE(bufoff, gbase, voff) do { _Pragma("unroll") for (int _i = 0; _i < 2; ++_i) \
        __builtin_amdgcn_global_load_lds((const unsigned*)((const char*)(gbase) + (voff)[_i]), (PG8_LAS unsigned*)(lds + (bufoff) + ldsw + _i * 8192), 16, 0, 0); } while (0)
#define PG8_LDA(dst, b, h) do { _Pragma("unroll") for (int m = 0; m < 4; ++m) _Pragma("unroll") for (int k = 0; k < 2; ++k) dst[m][k] = *(const PG8_LAS bf16x8*)(lds + PG8_SA(b, h) + aoff + m * 2048 + k * 1024); } while (0)
#define PG8_LDB(dst, b, h) do { _Pragma("unroll") for (int n = 0; n < 2; ++n) _Pragma("unroll") for (int k = 0; k < 2; ++k) dst[n][k] = *(const PG8_LAS bf16x8*)(lds + PG8_SB(b, h) + boff + n * 2048 + k * 1024); } while (0)
#define PG8_MMA(ai, bj, At, Bt) do { __builtin_amdgcn_s_setprio(1); _Pragma("unroll") for (int m = 0; m < 4; ++m) _Pragma("unroll") for (int n = 0; n < 2; ++n) _Pragma("unroll") for (int k = 0; k < 2; ++k) \
        acc[ai][bj][m][n] = __builtin_amdgcn_mfma_f32_16x16x32_bf16(Bt[n][k], At[m][k], acc[ai][bj][m][n], 0, 0, 0); __builtin_amdgcn_s_setprio(0); } while (0)
#define PG8_WAIT_V(n) asm volatile("s_waitcnt vmcnt(" #n ")" ::: "memory")
#define PG8_WAIT_L(n) asm volatile("s_waitcnt lgkmcnt(" #n ")" ::: "memory")
#define PG8_BAR __builtin_amdgcn_s_barrier()
#define PG8_SCHED __builtin_amdgcn_sched_barrier(0)
    Unit cur, nxt; int ui = 0;
    if (!S.next(0, cur)) return;
    f32x4 acc[2][2][4][2];
#pragma unroll
    for (int a = 0; a < 2; ++a)
#pragma unroll
        for (int b = 0; b < 2; ++b)
#pragma unroll
            for (int m = 0; m < 4; ++m)
#pragma unroll
                for (int n = 0; n < 2; ++n) acc[a][b][m][n] = (f32x4){0.f, 0.f, 0.f, 0.f};
    bf16x8 At[4][2], B0[2][2], B1[2][2];
    const char* cA = (const char*)g.A + (size_t)cur.pm * tstep; const char* cB = (const char*)g.Bt + (size_t)cur.pn * tstep;
    S.a_ready(cur);
    if constexpr (SP2) {
        PG8_STAGE(PG8_SB(0, 0), cB, voffB); PG8_STAGE(PG8_SB(0, 1), cB + hstep, voffB); PG8_STAGE(PG8_SA(0, 0), cA, voffA); PG8_STAGE(PG8_SA(0, 1), cA + hstep, voffA);
        if (wr == 1) PG8_BAR;
        PG8_WAIT_V(2); PG8_BAR;
        PG8_STAGE(PG8_SB(1, 0), cB + kstep, voffB); PG8_STAGE(PG8_SA(1, 0), cA + kstep, voffA); PG8_STAGE(PG8_SB(1, 1), cB + hstep + kstep, voffB);
        PG8_WAIT_V(6); PG8_BAR;
    } else {
        PG8_STAGE(PG8_SB(0, 0), cB, voffB); PG8_STAGE(PG8_SA(0, 0), cA, voffA); PG8_STAGE(PG8_SB(0, 1), cB + hstep, voffB); PG8_STAGE(PG8_SA(0, 1), cA + hstep, voffA);
        if (wr == 1) PG8_BAR;
        PG8_WAIT_V(4); PG8_BAR;
        PG8_STAGE(PG8_SB(1, 0), cB + kstep, voffB); PG8_STAGE(PG8_SA(1, 0), cA + kstep, voffA); PG8_STAGE(PG8_SB(1, 1), cB + hstep + kstep, voffB);
        PG8_WAIT_V(6); PG8_BAR;
    }
    for (;;) {
        const bool has_next = S.next(ui + 1, nxt);
        const char* nA = has_next ? (const char*)g.A + (size_t)nxt.pm * tstep : cA; const char* nB = has_next ? (const char*)g.Bt + (size_t)nxt.pn * tstep : cB;
        for (int t = 0; t < nt; t += 2) {
            const bool last = (t == nt - 2);
            const char* a1 = cA + (size_t)(t + 1) * kstep;
            const char* a2 = last ? nA : cA + (size_t)(t + 2) * kstep; const char* b2 = last ? nB : cB + (size_t)(t + 2) * kstep;
            const char* a3 = a2 + kstep; const char* b3 = b2 + kstep;
            if (last && has_next) S.a_ready(nxt);
            if constexpr (SP2) {
            PG8_LDB(B0, 0, 0); PG8_LDB(B1, 0, 1); PG8_SCHED; PG8_LDA(At, 0, 0); PG8_STAGE(PG8_SA(1, 1), a1 + hstep, voffA);
            PG8_WAIT_V(8); PG8_WAIT_L(0); PG8_BAR; PG8_MMA(0, 0, At, B0); PG8_MMA(0, 1, At, B1); PG8_BAR; PG8_SCHED;
            PG8_LDA(At, 0, 1); PG8_STAGE(PG8_SB(0, 0), b2, voffB); PG8_STAGE(PG8_SB(0, 1), b2 + hstep, voffB); PG8_STAGE(PG8_SA(0, 0), a2, voffA);
            PG8_WAIT_V(8); PG8_WAIT_L(0); PG8_BAR; PG8_MMA(1, 0, At, B0); PG8_MMA(1, 1, At, B1); PG8_BAR; PG8_SCHED;
            PG8_LDB(B0, 1, 0); PG8_LDB(B1, 1, 1); PG8_SCHED; PG8_LDA(At, 1, 0); PG8_STAGE(PG8_SA(0, 1), a2 + hstep, voffA);
            PG8_WAIT_V(8); PG8_WAIT_L(0); PG8_BAR; PG8_MMA(0, 0, At, B0); PG8_MMA(0, 1, At, B1); PG8_BAR; PG8_SCHED;
            PG8_LDA(At, 1, 1); PG8_STAGE(PG8_SB(1, 0), b3, voffB); PG8_STAGE(PG8_SB(1, 1), b3 + hstep, voffB); PG8_STAGE(PG8_SA(1, 0), a3, voffA);
            PG8_WAIT_V(8); PG8_WAIT_L(0); PG8_BAR; PG8_MMA(1, 0, At, B0); PG8_MMA(1, 1, At, B1); PG8_BAR; PG8_SCHED;
            } else {
            PG8_LDB(B0, 0, 0); PG8_SCHED; PG8_LDA(At, 0, 0); PG8_STAGE(PG8_SA(1, 1), a1 + hstep, voffA);
            PG8_WAIT_L(8); PG8_BAR; PG8_WAIT_L(0); PG8_MMA(0, 0, At, B0); PG8_BAR; PG8_SCHED;
            PG8_LDB(B1, 0, 1); PG8_STAGE(PG8_SB(0, 0), b2, voffB);
            PG8_BAR; PG8_WAIT_L(0); PG8_MMA(0, 1, At, B1); PG8_BAR;
            PG8_LDA(At, 0, 1); PG8_STAGE(PG8_SA(0, 0), a2, voffA);
            PG8_BAR; PG8_WAIT_L(0); PG8_MMA(1, 0, At, B0); PG8_BAR; PG8_SCHED;
            PG8_STAGE(PG8_SB(0, 1), b2 + hstep, voffB);
            PG8_WAIT_V(6); PG8_BAR; PG8_MMA(1, 1, At, B1); PG8_BAR;
            PG8_LDB(B0, 1, 0); PG8_SCHED; PG8_LDA(At, 1, 0); PG8_STAGE(PG8_SA(0, 1), a2 + hstep, voffA);
            PG8_WAIT_L(8); PG8_BAR; PG8_WAIT_L(0); PG8_MMA(0, 0, At, B0); PG8_BAR; PG8_SCHED;
            PG8_LDB(B1, 1, 1); PG8_STAGE(PG8_SB(1, 0), b3, voffB);
            PG8_BAR; PG8_WAIT_L(0); PG8_MMA(0, 1, At, B1); PG8_BAR;
            PG8_LDA(At, 1, 1); PG8_STAGE(PG8_SA(1, 0), a3, voffA);
            PG8_BAR; PG8_WAIT_L(0); PG8_MMA(1, 0, At, B0); PG8_BAR; PG8_SCHED;
            PG8_STAGE(PG8_SB(1, 1), b3 + hstep, voffB);
            PG8_WAIT_V(6); PG8_BAR; PG8_MMA(1, 1, At, B1); PG8_BAR;
            }
        }
        if constexpr (ALIGN_EPI) { if (wr == 0) PG8_BAR; }
        if constexpr (!Epi::AFTER_DRAIN) { E(acc, cur, wr, wc, fr, fq); S.done(cur); }
        if (!has_next) break;
#pragma unroll
        for (int a = 0; a < 2; ++a)
#pragma unroll
            for (int b = 0; b < 2; ++b)
#pragma unroll
                for (int m = 0; m < 4; ++m)
#pragma unroll
                    for (int n = 0; n < 2; ++n) acc[a][b][m][n] = (f32x4){0.f, 0.f, 0.f, 0.f};
        cur = nxt; cA = nA; cB = nB; ++ui;
        if constexpr (ALIGN_EPI) { if (wr == 1) PG8_BAR; }
    }
    PG8_WAIT_V(0);
    if constexpr (!ALIGN_EPI) { if (wr == 0) PG8_BAR; }
    PG8_BAR;
    if constexpr (Epi::AFTER_DRAIN) { E.fused(acc, cur, wr, wc, fr, fq, lds, wid, lane); S.done(cur); }
#undef PG8_SA
#undef PG8_SB
#undef PG8_STAGE
#undef PG8_LDA
#undef PG8_LDB
#undef PG8_MMA
#undef PG8_WAIT_V
#undef PG8_WAIT_L
#undef PG8_BAR
#undef PG8_SCHED
}
}

namespace fox {
constexpr int D = 128, PITCH = 2048, NW = 8, QBLK = 32, KVBLK = 64, QB = NW * QBLK;
constexpr int SHM_V = KVBLK * D * 2, SHM_K = KVBLK * D * 2;
constexpr int OFF_WS = 2 * SHM_V + 2 * SHM_K, OFF_BIAS = OFF_WS + NW * 64 * 4, LDS_BYTES = OFF_BIAS + 512;
constexpr float THR = 8.f;
using bf16 = __hip_bfloat16;
typedef short bf16x8 __attribute__((ext_vector_type(8)));
typedef short s16x4 __attribute__((ext_vector_type(4)));
typedef float f32x16 __attribute__((ext_vector_type(16)));
typedef float f32x4 __attribute__((ext_vector_type(4)));
typedef unsigned u32x4 __attribute__((ext_vector_type(4)));
#define KSWZ(row, colB) ((row) * 256 + ((colB) ^ (((row) & 7) << 4)))
#define SBAR() __builtin_amdgcn_sched_barrier(0)
__device__ __forceinline__ int v_st(int k, int c) { const int kk = (k & ~0xC) | ((k & 4) << 1) | ((k & 8) >> 1); return ((kk >> 3) * 4 + (c >> 5)) * 512 + ((kk & 7) * 32 + (c & 31)) * 2; }
__device__ __forceinline__ int v_rd_base(int lane) { return ((lane & 3) << 3) | (((lane >> 2) & 3) << 6) | (((lane >> 4) & 1) << 5) | (((lane >> 5) & 1) << 8); }
constexpr int v_rd_off(int d0, int ks, int half) { return d0 * 512 + ks * 4096 + half * 2048; }
__device__ __forceinline__ int crow(int r, int hi) { return (r & 3) + 8 * (r >> 2) + 4 * hi; }
__device__ __forceinline__ unsigned cvtpk(float lo, float hi) { unsigned r; asm volatile("v_cvt_pk_bf16_f32 %0, %1, %2" : "=v"(r) : "v"(lo), "v"(hi)); return r; }
__device__ __forceinline__ bf16x8 load8(const bf16* p) { return *reinterpret_cast<const bf16x8*>(p); }
__device__ __forceinline__ void mask_tile(f32x16& p0, f32x16& p1, int dq, unsigned W) {
    const float NEG = -__builtin_inff();
#pragma unroll
    for (int r = 0; r < 16; ++r) { const int c = (r & 3) + 8 * (r >> 2);
        if (c > dq) p0[r] = NEG;
        if (c + 32 > dq) p1[r] = NEG; }
}
__device__ __forceinline__ void add_bias(f32x16& p0, f32x16& p1, const float* bl) {
#pragma unroll
    for (int j = 0; j < 4; ++j) { const f32x4 b0 = *(const f32x4*)(bl + 8 * j), b1 = *(const f32x4*)(bl + 32 + 8 * j);
#pragma unroll
        for (int i = 0; i < 4; ++i) { p0[4 * j + i] += b0[i]; p1[4 * j + i] += b1[i]; } }
}
__device__ __forceinline__ void partialSM(f32x16& p0, f32x16& p1, float& m_reg, float& mn, float& alpha) {
    float pmax = p0[0]; for (int r = 1; r < 16; ++r) pmax = fmaxf(pmax, p0[r]); for (int r = 0; r < 16; ++r) pmax = fmaxf(pmax, p1[r]);
    { auto rr = __builtin_amdgcn_permlane32_swap(__float_as_uint(pmax), __float_as_uint(pmax), false, false);
      pmax = fmaxf(__uint_as_float(rr[0]), __uint_as_float(rr[1])); }
    if (__builtin_expect(__all((pmax - m_reg) <= THR), 1)) { mn = m_reg; alpha = 1.f; }
    else { mn = fmaxf(m_reg, pmax); alpha = __builtin_amdgcn_exp2f(m_reg - mn); m_reg = mn; }
    for (int r = 0; r < 16; ++r) p0[r] = p0[r] - mn; for (int r = 0; r < 16; ++r) p1[r] = p1[r] - mn;
    for (int r = 0; r < 16; ++r) p0[r] = __builtin_amdgcn_exp2f(p0[r]);
}
__device__ __forceinline__ void finishSM(f32x16& p0, f32x16& p1, float alpha, float& l_reg, bf16x8& pa0, bf16x8& pa1, bf16x8& pa2, bf16x8& pa3) {
    for (int r = 0; r < 16; ++r) p1[r] = __builtin_amdgcn_exp2f(p1[r]);
    float ps = 0; for (int r = 0; r < 16; ++r) ps += p0[r]; for (int r = 0; r < 16; ++r) ps += p1[r];
    { auto rr = __builtin_amdgcn_permlane32_swap(__float_as_uint(ps), __float_as_uint(ps), false, false);
      ps = __uint_as_float(rr[0]) + __uint_as_float(rr[1]); }
    l_reg = l_reg * alpha + ps;
#define PK4(P, B_, OUT) do { unsigned a0 = cvtpk(P[B_+0], P[B_+1]), a1 = cvtpk(P[B_+2], P[B_+3]);                          \
        unsigned b0 = cvtpk(P[B_+4], P[B_+5]), b1 = cvtpk(P[B_+6], P[B_+7]);                                             \
        auto r0 = __builtin_amdgcn_permlane32_swap(a0, b0, false, false); auto r1 = __builtin_amdgcn_permlane32_swap(a1, b1, false, false); \
        u32x4 w = {r0[0], r1[0], r0[1], r1[1]}; OUT = *reinterpret_cast<bf16x8*>(&w); } while (0)
    PK4(p0, 0, pa0); PK4(p0, 8, pa1); PK4(p1, 0, pa2); PK4(p1, 8, pa3);
#undef PK4
}
template <int KB>
__device__ __forceinline__ void qkt(f32x16& p0, f32x16& p1, const char* K_lds, const float* B_lds, int r32, int hi, const bf16x8* qr) {
    { const float* bl = B_lds + KB * 64 + 4 * hi;
#pragma unroll
      for (int j = 0; j < 4; ++j) { const f32x4 b0 = *(const f32x4*)(bl + 8 * j), b1 = *(const f32x4*)(bl + 32 + 8 * j);
#pragma unroll
          for (int i = 0; i < 4; ++i) { p0[4 * j + i] = b0[i]; p1[4 * j + i] = b1[i]; } } }
    const char* kb[4];
#pragma unroll
    for (int dd = 0; dd < 4; ++dd) kb[dd] = K_lds + KB * SHM_K + KSWZ(r32, (dd * 16 + hi * 8) * 2);
#pragma unroll
    for (int d0 = 0; d0 < 8; ++d0) { const char* a = kb[d0 & 3] + (d0 >> 2) * 128;
        bf16x8 b0 = *reinterpret_cast<const bf16x8*>(a);
        bf16x8 b1 = *reinterpret_cast<const bf16x8*>(a + 32 * 256);
        p0 = __builtin_amdgcn_mfma_f32_32x32x16_bf16(b0, qr[d0], p0, 0, 0, 0);
        p1 = __builtin_amdgcn_mfma_f32_32x32x16_bf16(b1, qr[d0], p1, 0, 0, 0); }
}
template <int VB>
__device__ __forceinline__ void pv_tile(f32x16* o, int vb0, bf16x8 pa0, bf16x8 pa1, bf16x8 pa2, bf16x8 pa3) {
#define TRRD(dst, off) asm volatile("ds_read_b64_tr_b16 %0, %1 offset:%2" : "=&v"(dst) : "v"(vb0), "i"(off) : "memory")
#define PV_D0(d0) do { s16x4 l0, l1, l2, l3, h0, h1, h2, h3; constexpr int b_ = VB * SHM_V + v_rd_off(d0, 0, 0); \
        TRRD(l0, b_); TRRD(h0, b_ + 2048); TRRD(l1, b_ + 4096); TRRD(h1, b_ + 6144); TRRD(l2, b_ + 8192); TRRD(h2, b_ + 10240); TRRD(l3, b_ + 12288); TRRD(h3, b_ + 14336); \
        asm volatile("s_waitcnt lgkmcnt(0)" ::: "memory"); SBAR();   \
        o[d0] = __builtin_amdgcn_mfma_f32_32x32x16_bf16(pa0, (bf16x8){l0[0], l0[1], l0[2], l0[3], h0[0], h0[1], h0[2], h0[3]}, o[d0], 0, 0, 0);   \
        o[d0] = __builtin_amdgcn_mfma_f32_32x32x16_bf16(pa1, (bf16x8){l1[0], l1[1], l1[2], l1[3], h1[0], h1[1], h1[2], h1[3]}, o[d0], 0, 0, 0);   \
        o[d0] = __builtin_amdgcn_mfma_f32_32x32x16_bf16(pa2, (bf16x8){l2[0], l2[1], l2[2], l2[3], h2[0], h2[1], h2[2], h2[3]}, o[d0], 0, 0, 0);   \
        o[d0] = __builtin_amdgcn_mfma_f32_32x32x16_bf16(pa3, (bf16x8){l3[0], l3[1], l3[2], l3[3], h3[0], h3[1], h3[2], h3[3]}, o[d0], 0, 0, 0); } while (0)
    PV_D0(0); PV_D0(1); PV_D0(2); PV_D0(3);
#undef PV_D0
#undef TRRD
}
struct Bases { bf16* Q; const bf16* K; const bf16* V; const float* NB; };
struct BlockRef { unsigned ro; int bh; int P0; };
#define RQ(R) (Bs.Q + (size_t)(R).ro + (size_t)(R).P0 * PITCH)
#define RK(R) (Bs.K + (size_t)(R).ro)
#define RV(R) (Bs.V + (size_t)(R).ro)
#define RNB(R) (Bs.NB + (size_t)(R).bh * 8192)
struct Seam { bf16x8 qr[8]; bf16x8 st_v0, st_v1, st_k0, st_k1; float st_b; };
#define ROWP(p, k0, rc) ((const bf16*)((const char*)((p) + ((size_t)(k0) + (rc)) * PITCH) + toffB))
#define VMW() asm volatile("s_waitcnt vmcnt(0)" ::: "memory")
#define VMWN(n) asm volatile("s_waitcnt vmcnt(%0)" :: "i"(n) : "memory")
#define SLOAD_H(R, k0) do { S.st_v0 = load8(ROWP(RV(R), k0, 0)); S.st_v1 = load8(ROWP(RV(R), k0, 32));              \
                         S.st_k0 = load8(ROWP(RK(R), k0, 0)); S.st_k1 = load8(ROWP(RK(R), k0, 32)); S.st_b = RNB(R)[(k0) + (tid & 63)]; } while (0)
#define SWRITE_HK(bf) do { *(bf16x8*)(K_lds + (bf) * SHM_K + kws) = S.st_k0; *(bf16x8*)(K_lds + (bf) * SHM_K + kws + 32 * 256) = S.st_k1; \
                           if (tid < 64) B_lds[(bf) * 64 + tid] = S.st_b; } while (0)
#define SWRITE_HV(bf) do { *(bf16x8*)(V_lds + (bf) * SHM_V + vst0) = S.st_v0; *(bf16x8*)(V_lds + (bf) * SHM_V + vst1) = S.st_v1; } while (0)
#define SWRITE_H(bf) do { SWRITE_HV(bf); SWRITE_HK(bf); } while (0)
__device__ __forceinline__ void prime(const Bases& Bs, const BlockRef& cur, char* lds, Seam& S, const int tid) {
    const int wid = __builtin_amdgcn_readfirstlane(tid >> 6), lane = tid & 63, r32 = lane & 31, hi = lane >> 5;
    const int sr = tid >> 4, sc = (tid & 15) * 8, kws = KSWZ(sr, sc * 2); char* K_lds = lds + 2 * SHM_V; float* B_lds = (float*)(lds + OFF_BIAS);
    const unsigned toffB = (unsigned)(sr * PITCH + sc) * 2u, qoffB = (unsigned)((wid * QBLK + r32) * PITCH + hi * 8) * 2u;
    for (int d0 = 0; d0 < 8; ++d0) S.qr[d0] = load8((const bf16*)((const char*)RQ(cur) + qoffB) + d0 * 16);
    SLOAD_H(cur, cur.P0 + QB - KVBLK); VMW(); SWRITE_HK(0);
    __syncthreads();
}
__device__ __forceinline__ void block(const Bases& Bs, const BlockRef& cur, const BlockRef& nxt, char* lds, Seam& S, const int tid) {
    const int wid = __builtin_amdgcn_readfirstlane(tid >> 6), lane = tid & 63, r32 = lane & 31, hi = lane >> 5;
    const unsigned W = 1u << 30;
    const int NT = (cur.P0 + QB) / KVBLK;
    const int qlo = cur.P0 + wid * QBLK;
    char* V_lds = lds; char* K_lds = lds + 2 * SHM_V; float* B_lds = (float*)(lds + OFF_BIAS);
    float* ws = (float*)(lds + OFF_WS) + wid * 64; float* li_l = ws, * al_l = ws + 32;
    float m_reg = -1e30f, l_reg = 0; f32x16 o[4] = {};
    const int sr = tid >> 4, sc = (tid & 15) * 8, vst0 = v_st(sr, sc), vst1 = v_st(32 + sr, sc), kws = KSWZ(sr, sc * 2);
    const unsigned toffB = (unsigned)(sr * PITCH + sc) * 2u;
    const int vb0 = (int)(uintptr_t)V_lds + v_rd_base(lane);
#define RESC(a) do { if (__any((a) < 1.f)) { if (hi == 0) al_l[r32] = (a); asm volatile("s_waitcnt lgkmcnt(0)" ::: "memory");              \
                     for (int d_ = 0; d_ < 4; ++d_) for (int r = 0; r < 16; ++r) o[d_][r] *= al_l[crow(r, hi)]; } } while (0)
#define KBASE(t) ((NT - 1 - (t)) * KVBLK)
#define MASKT(P0_, P1_, t) do { const int kb_ = KBASE(t); if (kb_ + KVBLK - 1 > qlo) { int tm_ = tid; asm volatile("" : "+v"(tm_)); mask_tile(P0_, P1_, qlo + (tm_ & 31) - 4 * ((tm_ >> 5) & 1) - kb_, W); } } while (0)
    constexpr int NQL = 8;
#define SEAM_K0() do { VMWN(NQL); SWRITE_HK(0); SBAR(); } while (0)
    f32x16 pA0, pA1, pB0, pB1; float mnA, mnB, alA, alB; bf16x8 pa0, pa1, pa2, pa3;
    SWRITE_HV(0); SBAR();
    SLOAD_H(cur, KBASE(1));
    SBAR(); qkt<0>(pA0, pA1, K_lds, B_lds, r32, hi, S.qr);
    MASKT(pA0, pA1, 0); partialSM(pA0, pA1, m_reg, mnA, alA);
    { VMW(); SWRITE_H(1); }
    __syncthreads();
#define HALF_STEP(PX0, PX1, mnX, alX, PY0, PY1, alY, t, KB, VB, SB) do {                                                      \
        SBAR(); qkt<KB>(PX0, PX1, K_lds, B_lds, r32, hi, S.qr);                                             \
        finishSM(PY0, PY1, alY, l_reg, pa0, pa1, pa2, pa3); SBAR();                                                           \
        if ((t) + 1 < NT) { SLOAD_H(cur, KBASE((t) + 1)); SBAR(); }                                               \
        pv_tile<VB>(o, vb0, pa0, pa1, pa2, pa3); MASKT(PX0, PX1, (t)); partialSM(PX0, PX1, m_reg, mnX, alX);                                        \
        __syncthreads();                                                                                                      \
        if ((t) + 1 < NT) { VMW(); SWRITE_H(SB); }                                                                          \
        RESC(alX); __syncthreads(); } while (0)
    for (int t = 1; t + 1 < NT; t += 2) {
        HALF_STEP(pB0, pB1, mnB, alB, pA0, pA1, alA, t, 1, 0, 0);
        HALF_STEP(pA0, pA1, mnA, alA, pB0, pB1, alB, t + 1, 0, 1, 1);
    }
    constexpr bool even = true;
    if (even) { SBAR(); qkt<1>(pB0, pB1, K_lds, B_lds, r32, hi, S.qr); SBAR(); }
    SLOAD_H(nxt, nxt.P0 + QB - KVBLK); SBAR();
    int tq_ = tid; asm volatile("" : "+v"(tq_));
    const unsigned qoffB = (unsigned)(((tq_ >> 6) * QBLK + (tq_ & 31)) * PITCH + ((tq_ >> 5) & 1) * 8) * 2u;
#pragma unroll
    for (int d0 = 0; d0 < 8; ++d0) S.qr[d0] = load8((const bf16*)((const char*)RQ(nxt) + qoffB) + d0 * 16);
    SBAR();
    finishSM(pA0, pA1, alA, l_reg, pa0, pa1, pa2, pa3); SBAR();
    pv_tile<0>(o, vb0, pa0, pa1, pa2, pa3);
    if (even) { MASKT(pB0, pB1, NT - 1); partialSM(pB0, pB1, m_reg, mnB, alB); __syncthreads(); RESC(alB);
        finishSM(pB0, pB1, alB, l_reg, pa0, pa1, pa2, pa3); SBAR(); pv_tile<1>(o, vb0, pa0, pa1, pa2, pa3); }
    SBAR(); SEAM_K0();
    if (hi == 0) li_l[r32] = l_reg; asm volatile("s_waitcnt lgkmcnt(0)" ::: "memory");
    float rli[16];
#pragma unroll
    for (int r = 0; r < 16; ++r) rli[r] = __builtin_amdgcn_rcpf(li_l[crow(r, hi)]);
    int to_ = tid; asm volatile("" : "+v"(to_));
    const unsigned ooffB = (unsigned)(((to_ >> 6) * QBLK + 4 * ((to_ >> 5) & 1)) * PITCH + (to_ & 31)) * 2u;
    char* Ow = (char*)RQ(cur) + ooffB;
#pragma unroll
    for (int r = 0; r < 16; ++r) { const int orow0 = (r & 3) + 8 * (r >> 2);
#pragma unroll
        for (int d0 = 0; d0 < 4; ++d0) { const float v = o[d0][r] * rli[r];
            const float vn = __shfl_xor(v, 1);
            if ((r32 & 1) == 0) *(unsigned*)(Ow + (size_t)(orow0 * PITCH + d0 * 32) * 2) = cvtpk(v, vn); } }
    __syncthreads();
#undef RESC
#undef KBASE
#undef MASKT
#undef SEAM_K0
#undef HALF_STEP
}
#undef ROWP
#undef RQ
#undef RK
#undef RV
#undef RNB
#undef VMW
#undef VMWN
#undef SLOAD_H
#undef SWRITE_HK
#undef SWRITE_HV
#undef SWRITE_H
#undef KSWZ
#undef SBAR
}

#define LAS __attribute__((address_space(3)))
typedef unsigned short bf16_t;
typedef unsigned v4u __attribute__((ext_vector_type(4)));
typedef unsigned v2u __attribute__((ext_vector_type(2)));
typedef float f32x4 __attribute__((ext_vector_type(4)));
typedef short bf16x8 __attribute__((ext_vector_type(8)));
typedef short s16x4 __attribute__((ext_vector_type(4)));
#define LDS_WAIT() asm volatile("s_waitcnt lgkmcnt(0)" ::: "memory")

constexpr int NWAVES = 8;
constexpr int M = 16384, DM = 2048, DFF = 5632, T = 8192, NCH = 128;
constexpr int IN_W = 18464;
constexpr float EPS = 1e-6f;
constexpr size_t MiB = 1u << 20;
constexpr size_t WS_CTL = 0;
constexpr size_t WS_PS = 1 * MiB;
constexpr size_t WS_ACH = 3 * MiB;
constexpr size_t WS_NB = 4 * MiB;
constexpr size_t WS_OSQ = 530 * MiB;
constexpr size_t WS_RS = 6 * MiB;
constexpr size_t WS_WB = 8 * MiB;
constexpr size_t WS_WA = 40 * MiB;
constexpr size_t WS_XN = 114 * MiB;
constexpr size_t WS_FV = 178 * MiB, WS_FK = 242 * MiB, WS_FQ = 306 * MiB, WS_GV = 370 * MiB, WS_GQ = 434 * MiB, WS_GK = 466 * MiB, WS_KT = 498 * MiB, WS_END = 538 * MiB;
constexpr size_t WS_H = WS_FV;
constexpr size_t WS_MGF = WS_FV;
constexpr size_t WS_SG = WS_GQ, WS_SF = WS_FK;
constexpr int LDS_BYTES = 153600;

__device__ __forceinline__ unsigned f2bf(float f) { unsigned u = __builtin_bit_cast(unsigned, f); return (u + 0x7fffu + ((u >> 16) & 1u)) >> 16; }
__device__ __forceinline__ unsigned pk2(float lo, float hi) { return f2bf(lo) | (f2bf(hi) << 16); }
__device__ __forceinline__ float bfu(unsigned short h) { return __uint_as_float((unsigned)h << 16); }
__device__ __forceinline__ float wave_sum(float v) {
#pragma unroll
    for (int o = 1; o < 64; o <<= 1) v += __shfl_xor(v, o);
    return v;
}
__device__ __forceinline__ float logsig(float z) { return fminf(z, 0.f) - __logf(1.0f + __expf(-fabsf(z))); }

typedef float f32x2m __attribute__((ext_vector_type(2)));
__device__ __forceinline__ void tr_item(const float* W, int N, bf16_t* WT, int ldk, int k0, int drow0, int a0, int b0, int a1, int b1, const float* gk, LAS float* scr, int lane) {
    const int n = 2 * (lane & 31), within = n & 31; const int sa = (n >> 5) ? a1 : a0, sb = (n >> 5) ? b1 : b0; const int sc = (within < 16) ? sa + within : sb + (within - 16);
#pragma unroll 8
    for (int i = 0; i < 32; ++i) { const int kk = 2 * i + (lane >> 5); const float gg = gk ? gk[k0 + kk] : 1.0f;
        const f32x2m v = __builtin_nontemporal_load((const f32x2m*)(W + (size_t)(k0 + kk) * N + sc));     scr[kk * 65 + n] = v.x * gg; scr[kk * 65 + n + 1] = v.y * gg; }
    LDS_WAIT(); asm volatile("" ::: "memory");
    const int c = lane & 7;
#pragma unroll
    for (int j = 0; j < 8; ++j) { const int n2 = (lane >> 3) + 8 * j; const LAS float* s = scr + (8 * c) * 65 + n2;
        v4u o; o.x = pk2(s[0 * 65], s[1 * 65]); o.y = pk2(s[2 * 65], s[3 * 65]); o.z = pk2(s[4 * 65], s[5 * 65]); o.w = pk2(s[6 * 65], s[7 * 65]);
        *(v4u*)(WT + (size_t)(drow0 + n2) * ldk + k0 + 8 * c) = o; }
    LDS_WAIT(); asm volatile("" ::: "memory");
}
enum { CM_ID = 0, CM_SWIGLU = 1, CM_WIN = 2 };
__device__ __forceinline__ void conv_map(int mode, int d0, int& srcA, int& srcB) {
    if (mode == CM_ID) { srcA = d0; srcB = d0 + 16; }
    else if (mode == CM_SWIGLU) { const int tile = d0 >> 8, w = d0 & 255; srcA = (w >> 7) * DFF + tile * 128 + (w & 127); srcB = srcA + 16; }
    else { int s;
        if (d0 < 4096) s = d0;
        else if (d0 < 10240) s = 6160 + (d0 - 4096);
        else if (d0 < 12288) s = 4096 + (d0 - 10240);
        else if (d0 < 18432) s = 12320 + (d0 - 12288);
        else { srcA = 6144; srcB = 12304; return; }
        srcA = s; srcB = s + 16; }
}
__device__ __forceinline__ void conv_range(const float* W, int K, int N, bf16_t* WT, int ldk, int ndest, int mode, const float* gk, int& base, int gw, int NGW, LAS float* scr, int lane) {
    const int nblk = (ndest + 63) / 64, nitems = (K / 64) * nblk;
    int it = gw - (base % NGW); if (it < 0) it += NGW;
    for (; it < nitems; it += NGW) { const int kb = it / nblk, nb = it % nblk; int a0, b0, a1, b1; conv_map(mode, nb * 64, a0, b0); conv_map(mode, nb * 64 + 32, a1, b1);
        tr_item(W, N, WT, ldk, kb * 64, nb * 64, a0, b0, a1, b1, gk, scr, lane); }
    base += nitems;
}
__device__ __forceinline__ void rms_rows_bf16(const float* x, const float* g, bf16_t* out, int gw, int NGW, int lane) {
    f32x4 gv[8];
#pragma unroll
    for (int j = 0; j < 8; ++j) gv[j] = ((const f32x4*)g)[lane + 64 * j];
    f32x4 nx[8];
    if (gw < M) { const f32x4* xr = (const f32x4*)(x + (size_t)gw * DM) + lane;
#pragma unroll
        for (int j = 0; j < 8; ++j) nx[j] = __builtin_nontemporal_load(xr + 64 * j); }
    for (int m = gw; m < M; m += NGW) {
        f32x4 v[8]; float s = 0.f;
#pragma unroll
        for (int j = 0; j < 8; ++j) v[j] = nx[j];
        if (m + NGW < M) { const f32x4* xr = (const f32x4*)(x + (size_t)(m + NGW) * DM) + lane;
#pragma unroll
            for (int j = 0; j < 8; ++j) nx[j] = __builtin_nontemporal_load(xr + 64 * j); }
#pragma unroll
        for (int j = 0; j < 8; ++j) s += (v[j].x * v[j].x + v[j].y * v[j].y) + (v[j].z * v[j].z + v[j].w * v[j].w);
        const float rstd = __builtin_amdgcn_rsqf(wave_sum(s) * (1.f / DM) + EPS);
        v2u* o8 = (v2u*)(out + (size_t)m * DM) + lane;
#pragma unroll
        for (int j = 0; j < 8; ++j) { v2u w; w.x = pk2(v[j].x * rstd * gv[j].x, v[j].y * rstd * gv[j].y); w.y = pk2(v[j].z * rstd * gv[j].z, v[j].w * rstd * gv[j].w); o8[64 * j] = w; }
    }
}
__device__ __forceinline__ void rms_rows_f32(float* x, const float* g, int gw, int NGW, int lane) {
    f32x4 gv[8];
#pragma unroll
    for (int j = 0; j < 8; ++j) gv[j] = ((const f32x4*)g)[lane + 64 * j];
    f32x4 nx[8];
    if (gw < M) { const f32x4* xr = (const f32x4*)(x + (size_t)gw * DM) + lane;
#pragma unroll
        for (int j = 0; j < 8; ++j) nx[j] = xr[64 * j]; }
    for (int m = gw; m < M; m += NGW) {
        f32x4* xw = (f32x4*)(x + (size_t)m * DM) + lane; f32x4 v[8]; float s = 0.f;
#pragma unroll
        for (int j = 0; j < 8; ++j) v[j] = nx[j];
        if (m + NGW < M) { const f32x4* xr = (const f32x4*)(x + (size_t)(m + NGW) * DM) + lane;
#pragma unroll
            for (int j = 0; j < 8; ++j) nx[j] = xr[64 * j]; }
#pragma unroll
        for (int j = 0; j < 8; ++j) s += (v[j].x * v[j].x + v[j].y * v[j].y) + (v[j].z * v[j].z + v[j].w * v[j].w);
        const float rstd = __builtin_amdgcn_rsqf(wave_sum(s) * (1.f / DM) + EPS);
#pragma unroll
        for (int j = 0; j < 8; ++j) __builtin_nontemporal_store(v[j] * rstd * gv[j], xw + 64 * j);
    }
}
__device__ __forceinline__ void small_proj(const bf16_t* XN, const bf16_t* Wsm, float* PS, const float* rs, LAS unsigned char* lds, int wg, int G, int wid, int lane) {
    const int n16 = lane & 15, kq = lane >> 4; LAS f32x4* red = (LAS f32x4*)lds;
    for (int item = wg; item < M / 64; item += G) {
        const int rg = wid & 3, kh = wid >> 2, row = item * 64 + rg * 16 + n16;
        const bf16_t* ap = XN + (size_t)row * DM + kh * 1024 + kq * 8;
        const bf16_t* bp0 = Wsm + (size_t)n16 * DM + kh * 1024 + kq * 8; const bf16_t* bp1 = bp0 + (size_t)16 * DM;
        f32x4 a0 = {0.f, 0.f, 0.f, 0.f}, a1 = {0.f, 0.f, 0.f, 0.f};
#pragma unroll 8
        for (int ks = 0; ks < 32; ++ks) { const bf16x8 a = *(const bf16x8*)(ap + ks * 32), b0 = *(const bf16x8*)(bp0 + ks * 32), b1 = *(const bf16x8*)(bp1 + ks * 32);
            a0 = __builtin_amdgcn_mfma_f32_16x16x32_bf16(a, b0, a0, 0, 0, 0); a1 = __builtin_amdgcn_mfma_f32_16x16x32_bf16(a, b1, a1, 0, 0, 0); }
        if (kh == 1) { red[(rg * 2 + 0) * 64 + lane] = a0; red[(rg * 2 + 1) * 64 + lane] = a1; }
        __syncthreads();
        if (kh == 0) { a0 += red[(rg * 2 + 0) * 64 + lane]; a1 += red[(rg * 2 + 1) * 64 + lane];
#pragma unroll
            for (int r = 0; r < 4; ++r) { const int row = item * 64 + rg * 16 + 4 * kq + r; const float rstd = __builtin_amdgcn_rsqf(rs[row] * (1.0f / 2048.0f) + 1e-6f); float* pr = PS + (size_t)row * 32; pr[n16] = a0[r] * rstd; pr[16 + n16] = a1[r] * rstd; } }
        __syncthreads();
    }
}
__device__ __forceinline__ void fox_qk_norm(bf16_t* FQ, bf16_t* FK, const float* gq, const float* gk, int gw, int NGW, int lane) {
    const int d = (lane & 15) * 8; float gqv[8], gkv[8];
#pragma unroll
    for (int i = 0; i < 8; ++i) { gqv[i] = gq[d + i] * (0.08838834764831845f * 1.4426950408889634f); gkv[i] = gk[d + i]; }
    v4u nx[2][4];
    if (gw < M) {
#pragma unroll
        for (int j = 0; j < 4; ++j) { nx[0][j] = *((const v4u*)(FQ + (size_t)gw * DM + j * 512) + lane); nx[1][j] = *((const v4u*)(FK + (size_t)gw * DM + j * 512) + lane); } }
    for (int m = gw; m < M; m += NGW) {
        v4u cur[2][4];
#pragma unroll
        for (int w = 0; w < 2; ++w)
#pragma unroll
            for (int j = 0; j < 4; ++j) cur[w][j] = nx[w][j];
        if (m + NGW < M) {
#pragma unroll
            for (int j = 0; j < 4; ++j) { nx[0][j] = *((const v4u*)(FQ + (size_t)(m + NGW) * DM + j * 512) + lane); nx[1][j] = *((const v4u*)(FK + (size_t)(m + NGW) * DM + j * 512) + lane); } }
#pragma unroll
        for (int which = 0; which < 2; ++which) { bf16_t* rowp = (which ? FK : FQ) + (size_t)m * DM;
#pragma unroll
            for (int j = 0; j < 4; ++j) { v4u* p = (v4u*)(rowp + j * 512) + lane; const v4u w = cur[which][j]; float v[8] = {__uint_as_float(w.x << 16), __uint_as_float(w.x & 0xffff0000u), __uint_as_float(w.y << 16), __uint_as_float(w.y & 0xffff0000u),
                    __uint_as_float(w.z << 16), __uint_as_float(w.z & 0xffff0000u), __uint_as_float(w.w << 16), __uint_as_float(w.w & 0xffff0000u)};
                float s = 0.f;
#pragma unroll
                for (int i = 0; i < 8; ++i) s += v[i] * v[i];
                s += __shfl_xor(s, 1); s += __shfl_xor(s, 2); s += __shfl_xor(s, 4); s += __shfl_xor(s, 8);
                const float rstd = __builtin_amdgcn_rsqf(s * (1.f / 128.f) + EPS);
                v4u o;
                if (which == 0) { o.x = pk2(v[0] * rstd * gqv[0], v[1] * rstd * gqv[1]); o.y = pk2(v[2] * rstd * gqv[2], v[3] * rstd * gqv[3]); o.z = pk2(v[4] * rstd * gqv[4], v[5] * rstd * gqv[5]); o.w = pk2(v[6] * rstd * gqv[6], v[7] * rstd * gqv[7]); }
                else { o.x = pk2(v[0] * rstd * gkv[0], v[1] * rstd * gkv[1]); o.y = pk2(v[2] * rstd * gkv[2], v[3] * rstd * gkv[3]); o.z = pk2(v[4] * rstd * gkv[4], v[5] * rstd * gkv[5]); o.w = pk2(v[6] * rstd * gkv[6], v[7] * rstd * gkv[7]); }
                *p = o; } }
    }
}
__device__ __forceinline__ void fox_cumsum(const float* PS, const float* b_f, float* NB, int bh, LAS unsigned char* lds, int wid, int lane) {
    const int b = bh >> 4, h = bh & 15; const float bf = b_f[h]; LAS float* tot = (LAS float*)lds;
    const int t0 = wid * 1024 + lane * 16;
    const float* src = PS + ((size_t)b * T + t0) * 32 + 16 + h;
    float ls[16]; float s = 0.f;
#pragma unroll
    for (int i = 0; i < 16; ++i) { ls[i] = logsig(src[(size_t)i * 32] + bf); s += ls[i]; }
    float incl = s;
#pragma unroll
    for (int o = 1; o < 64; o <<= 1) { const float t = __shfl_up(incl, o); if (lane >= o) incl += t; }
    if (lane == 63) tot[wid] = incl;
    __syncthreads();
    float run = incl - s;
#pragma unroll
    for (int w = 0; w < 8; ++w) if (w < wid) run += tot[w];
    float* dst = NB + (size_t)bh * T + t0;
#pragma unroll
    for (int q = 0; q < 4; ++q) { f32x4 o;
#pragma unroll
        for (int i = 0; i < 4; ++i) { run += ls[4 * q + i]; o[i] = -run * 1.4426950408889634f; }
        *(f32x4*)(dst + 4 * q) = o; }
    __syncthreads();
}
__device__ __forceinline__ void gla_prep_item(int item, const float* PS, const float* w_up, const float* b_a, const bf16_t* GK, bf16_t* KT, float* ACH, LAS unsigned char* lds, int tid) {
    const int h = item & 3, c = (item >> 2) & 127, b = item >> 9; const int col = tid & 255, half = tid >> 8;
    LAS float* alr_s = (LAS float*)lds; LAS float* tot_s = alr_s + 64 * 16;
    const size_t row0 = (size_t)b * T + (size_t)c * 64;
#pragma unroll
    for (int i = 0; i < 2; ++i) { const int e = tid + 512 * i; alr_s[e] = PS[(row0 + (e >> 4)) * 32 + (e & 15)]; }
    float w[16];
#pragma unroll
    for (int j = 0; j < 16; ++j) w[j] = w_up[j * 1024 + h * 256 + col];
    const float ba = b_a[h * 256 + col];
    __syncthreads();
    float Gv[32]; float run = 0.f;
#pragma unroll
    for (int r = 0; r < 32; ++r) { const LAS f32x4* ar = (const LAS f32x4*)(alr_s + (half * 32 + r) * 16); float z = ba;
#pragma unroll
        for (int q = 0; q < 4; ++q) { const f32x4 a = ar[q]; z += a.x * w[4 * q] + a.y * w[4 * q + 1] + a.z * w[4 * q + 2] + a.w * w[4 * q + 3]; }
        run += logsig(z) * (1.0f / 16.0f); Gv[r] = run; }
    tot_s[half * 256 + col] = run;
    __syncthreads();
    const float t0 = tot_s[col], t1 = tot_s[256 + col], Gend = t0 + t1, off = half ? t0 : 0.f;
    const bf16_t* kp = GK + (row0 + half * 32) * 1024 + h * 256 + col;
    unsigned pk[16];
#pragma unroll
    for (int r = 0; r < 32; r += 2) { const float k0 = bfu(kp[(size_t)r * 1024]) * __expf(Gend - (Gv[r] + off)), k1 = bfu(kp[(size_t)(r + 1) * 1024]) * __expf(Gend - (Gv[r + 1] + off)); pk[r >> 1] = pk2(k0, k1); }
    v4u* dst = (v4u*)(KT + ((((size_t)b * NCH + c) * 4 + h) * 256 + col) * 64 + half * 32);
#pragma unroll
    for (int q = 0; q < 4; ++q) dst[q] = (v4u){pk[4 * q], pk[4 * q + 1], pk[4 * q + 2], pk[4 * q + 3]};
    if (half == 0) ACH[((size_t)b * NCH + c) * 1024 + h * 256 + col] = __expf(Gend);
    __syncthreads();
}
constexpr int GL_K = 0, GL_Q = 32768, GL_A = 65536, GL_BUF = 66560, GL_X = 2 * GL_BUF, GL_END = GL_X + 16384;
__device__ __forceinline__ void gla_scan(int unit, const bf16_t* KT, const bf16_t* GQ, bf16_t* GV, const float* ACH, float* OSQ, LAS unsigned char* lds, int tid, int wid, int lane) {
    const int slab = unit & 7, h = (unit >> 3) & 3, b = unit >> 5; const int n16 = lane & 15, q4 = lane >> 4, dvg = wid & 3, dkh = wid >> 2;
    f32x4 S[8];
#pragma unroll
    for (int i = 0; i < 8; ++i) S[i] = (f32x4){0.f, 0.f, 0.f, 0.f};
    v4u rk[4], rq[4], ra; unsigned short rv[16];
    const size_t vcol = (size_t)h * 512 + slab * 64 + dvg * 16 + n16;
#define GL_LOAD(c) do { const bf16_t* kt = KT + (((size_t)b * NCH + (c)) * 4 + h) * 256 * 64; const bf16_t* qc = GQ + ((size_t)b * T + (size_t)(c) * 64) * 1024 + h * 256; \
        _Pragma("unroll") for (int i = 0; i < 4; ++i) { const int p = tid + 512 * i; rk[i] = *(const v4u*)(kt + (size_t)p * 8); rq[i] = *(const v4u*)(qc + (size_t)(p >> 5) * 1024 + (p & 31) * 8); } \
        if (tid < 64) ra = *(const v4u*)(ACH + ((size_t)b * NCH + (c)) * 1024 + h * 256 + tid * 4); \
        const bf16_t* vc = GV + ((size_t)b * T + (size_t)(c) * 64) * 2048 + vcol; \
        _Pragma("unroll") for (int i = 0; i < 16; ++i) rv[i] = vc[(size_t)((i >> 3) * 32 + 8 * q4 + (i & 7)) * 2048]; } while (0)
#define GL_STORE(buf) do { LAS unsigned char* bb = lds + (buf) * GL_BUF; \
        _Pragma("unroll") for (int i = 0; i < 4; ++i) { const int p = tid + 512 * i; *(LAS v4u*)(bb + GL_K + (p >> 3) * 128 + (((p & 7) ^ ((p >> 3) & 7)) * 16)) = rk[i]; *(LAS v4u*)(bb + GL_Q + (p >> 5) * 512 + (((p & 31) ^ ((p >> 5) & 15)) * 16)) = rq[i]; } \
        if (tid < 64) *(LAS v4u*)(bb + GL_A + tid * 16) = ra; } while (0)
    GL_LOAD(0); GL_STORE(0);
    __syncthreads();
    for (int c = 0; c < NCH; ++c) {
        const int buf = c & 1; LAS unsigned char* bb = lds + buf * GL_BUF;
        bf16x8 vf[2];
#pragma unroll
        for (int ks = 0; ks < 2; ++ks) { v4u w; w.x = rv[8 * ks] | ((unsigned)rv[8 * ks + 1] << 16); w.y = rv[8 * ks + 2] | ((unsigned)rv[8 * ks + 3] << 16); w.z = rv[8 * ks + 4] | ((unsigned)rv[8 * ks + 5] << 16); w.w = rv[8 * ks + 6] | ((unsigned)rv[8 * ks + 7] << 16); vf[ks] = __builtin_bit_cast(bf16x8, w); }
        if (c + 1 < NCH) GL_LOAD(c + 1);
#pragma unroll
        for (int i = 0; i < 8; ++i) { const int row = dkh * 128 + 16 * i + n16; const f32x4 av = *(const LAS f32x4*)(bb + GL_A + (dkh * 128 + 16 * i + 4 * q4) * 4); S[i] = S[i] * av;
#pragma unroll
            for (int ks = 0; ks < 2; ++ks) { const bf16x8 a = *(const LAS bf16x8*)(bb + GL_K + row * 128 + (((4 * ks + q4) ^ (n16 & 7)) * 16));
                S[i] = __builtin_amdgcn_mfma_f32_16x16x32_bf16(a, vf[ks], S[i], 0, 0, 0); } }
        f32x4 o[4];
#pragma unroll
        for (int ct = 0; ct < 4; ++ct) o[ct] = (f32x4){0.f, 0.f, 0.f, 0.f};
#pragma unroll
        for (int j = 0; j < 4; ++j) { v4u bw; bw.x = pg8::cvt_pk_bf16(S[2 * j][0], S[2 * j][1]); bw.y = pg8::cvt_pk_bf16(S[2 * j][2], S[2 * j][3]); bw.z = pg8::cvt_pk_bf16(S[2 * j + 1][0], S[2 * j + 1][1]); bw.w = pg8::cvt_pk_bf16(S[2 * j + 1][2], S[2 * j + 1][3]);
            const bf16x8 bfr = __builtin_bit_cast(bf16x8, bw);
#pragma unroll
            for (int ct = 0; ct < 4; ++ct) { const LAS unsigned char* qrow = bb + GL_Q + (16 * ct + n16) * 512;
                const int e0 = dkh * 32 + 8 * j + q4; const v2u lo = *(const LAS v2u*)(qrow + ((e0 ^ (n16 << 1)) * 8)), hi = *(const LAS v2u*)(qrow + (((e0 + 4) ^ (n16 << 1)) * 8)); const v4u aw = {lo.x, lo.y, hi.x, hi.y};
                o[ct] = __builtin_amdgcn_mfma_f32_16x16x32_bf16(__builtin_bit_cast(bf16x8, aw), bfr, o[ct], 0, 0, 0); } }
        LAS f32x4* xch = (LAS f32x4*)(lds + GL_X);
        if (dkh == 0) { xch[((dvg * 2 + 0) * 2 + 0) * 64 + lane] = o[2]; xch[((dvg * 2 + 0) * 2 + 1) * 64 + lane] = o[3]; }
        else          { xch[((dvg * 2 + 1) * 2 + 0) * 64 + lane] = o[0]; xch[((dvg * 2 + 1) * 2 + 1) * 64 + lane] = o[1]; }
        __syncthreads();
#pragma unroll
        for (int t = 0; t < 2; ++t) { const int ct = 2 * dkh + t; const f32x4 mine = dkh == 0 ? o[t] : o[2 + t]; const f32x4 s = mine + xch[((dvg * 2 + (1 - dkh)) * 2 + t) * 64 + lane];
            bf16_t* oc = GV + ((size_t)b * T + (size_t)c * 64 + 16 * ct + 4 * q4) * 2048 + vcol;
            float* osqp = OSQ + ((size_t)b * T + (size_t)c * 64 + 16 * ct + 4 * q4) * 128 + h * 32 + slab * 4 + dvg;
#pragma unroll
            for (int r = 0; r < 4; ++r) { const float v = s[r] * 0.0625f; float sq = v * v;
                sq += __shfl_xor(sq, 1); sq += __shfl_xor(sq, 2); sq += __shfl_xor(sq, 4); sq += __shfl_xor(sq, 8);
                if (n16 == 0) osqp[(size_t)r * 128] = sq;
                oc[(size_t)r * 2048] = (bf16_t)f2bf(v); } }
        if (c + 1 < NCH) GL_STORE(buf ^ 1);
        __syncthreads();
    }
#undef GL_LOAD
#undef GL_STORE
}

#define XB_TMO      128
#define XB_XCNT(j)  (256  + 64 * (j))
#define XB_XSUB(j)  (1280 + 64 * (j))
#define XB_XGEN(j)  (2304 + 64 * (j))
#define XB_TOP      3328
#define XB_TOPGEN   3392
#define XCD_BAR_WORDS 3456
#define XB_SPIN_CAP (1u << 18)

__device__ __forceinline__ unsigned xb_ld(unsigned* p)              { return __hip_atomic_load(p, __ATOMIC_RELAXED, __HIP_MEMORY_SCOPE_AGENT); }
__device__ __forceinline__ unsigned xb_add(unsigned* p, unsigned v) { return __hip_atomic_fetch_add(p, v, __ATOMIC_RELAXED, __HIP_MEMORY_SCOPE_AGENT); }
__device__ __forceinline__ unsigned xb_xcc_id() { return (unsigned)__builtin_amdgcn_s_getreg((3 << 11) | 20) & 0xFu; }
#define XB_SPIN(cond, bar) do { unsigned _sp = 0; while (cond) { __builtin_amdgcn_s_sleep(1); \
    if ((++_sp & 255u) == 0u) { if (xb_ld(&(bar)[XB_TMO])) break; if (_sp > XB_SPIN_CAP) { atomicAdd(&(bar)[XB_TMO], 1u); break; } } } } while (0)

struct XcdBarrier {
    unsigned* bar; unsigned x;
    volatile LAS unsigned* st;
};

__device__ __forceinline__ XcdBarrier xcd_barrier_post(unsigned* bar, volatile LAS unsigned* st) {
    XcdBarrier b; b.bar = bar; b.x = xb_xcc_id(); b.st = st;
    if (threadIdx.x == 0) (void)xb_add(&bar[XB_XCNT(b.x)], 1u);
    return b;
}
__device__ __forceinline__ void xcd_barrier_complete(unsigned* bar, unsigned x, unsigned& nloc, unsigned& nx) {
    const unsigned G = gridDim.x * gridDim.y * gridDim.z;
    unsigned sum, cnt, mine, sp = 0u;
    for (;;) {
        sum = 0u; cnt = 0u; mine = 0u;
#pragma unroll
        for (unsigned j = 0; j < 16; ++j) { const unsigned c = xb_ld(&bar[XB_XCNT(j)]); sum += c; cnt += (c > 0u) ? 1u : 0u; mine = (j == x) ? c : mine; }
        if (sum == G) break;
        __builtin_amdgcn_s_sleep(1);
        if ((++sp & 255u) == 0u) { if (xb_ld(&bar[XB_TMO])) break; if (sp > XB_SPIN_CAP) { atomicAdd(&bar[XB_TMO], 1u); break; } }
    }
    nloc = mine > 0u ? mine : 1u; nx = cnt > 0u ? cnt : 1u;
}

__device__ __forceinline__ void xcd_barrier(const XcdBarrier& b) {
    asm volatile("s_waitcnt vmcnt(0)" ::: "memory");
    __syncthreads();
    if (threadIdx.x == 0) {
        unsigned* bar = b.bar;
        __builtin_amdgcn_s_waitcnt(0);
        unsigned nloc = b.st[0], nx = b.st[1];
        if (nloc == 0u) { xcd_barrier_complete(bar, b.x, nloc, nx); b.st[0] = nloc; b.st[1] = nx; }
        const unsigned old = xb_add(&bar[XB_XSUB(b.x)], 1u);
        const unsigned gen = old / nloc;
        if (old + 1u == (gen + 1u) * nloc) {
            __builtin_amdgcn_fence(__ATOMIC_RELEASE, "agent");
            asm volatile("s_waitcnt vmcnt(0)" ::: "memory");
            const unsigned og = xb_add(&bar[XB_TOP], 1u);
            const unsigned tg = og / nx;
            if (og + 1u == (tg + 1u) * nx) xb_add(&bar[XB_TOPGEN], 1u);
            else XB_SPIN(xb_ld(&bar[XB_TOPGEN]) == tg, bar);
            __builtin_amdgcn_fence(__ATOMIC_ACQUIRE, "agent");
            xb_add(&bar[XB_XGEN(b.x)], 1u);
            asm volatile("s_waitcnt vmcnt(0)" ::: "memory");
        } else {
            XB_SPIN(xb_ld(&bar[XB_XGEN(b.x)]) == gen, bar);
            __builtin_amdgcn_fence(__ATOMIC_ACQUIRE, "agent");
            asm volatile("s_waitcnt vmcnt(0)" ::: "memory");
        }
    }
    __syncthreads();
}

constexpr int CW_BAR = 4096;
constexpr int LDS_MISC = LDS_BYTES - 64;
#ifndef PHMASK
#define PHMASK 0x3fff
#endif
struct Args { const float* in[20]; float* out; unsigned char* ws; int ph_lo, ph_hi; };
constexpr int N_PHASES = 14;
constexpr int N_GLA_UNITS = 64, N_ATT_ITEMS = 1024;

#define GP(T, p) ((T*)(__attribute__((address_space(1))) T*)(p))
#define PH_BEGIN \
        int tidp_ = threadIdx.x; asm volatile("" : "+v"(tidp_)); \
        const int tid = tidp_, lane = tid & 63, wid = __builtin_amdgcn_readfirstlane(tid >> 6); \
        const int G = gridDim.x, wg = blockIdx.x, gw = wg * NWAVES + wid, NGW = G * NWAVES; \
        __attribute__((address_space(1))) unsigned char* ws_ = (__attribute__((address_space(1))) unsigned char*)args.ws; asm volatile("" : "+s"(ws_)); unsigned char* ws = (unsigned char*)ws_; \
        float* out = GP(float, args.out); \
        bf16_t* XN = (bf16_t*)(ws + WS_XN); bf16_t* WA = (bf16_t*)(ws + WS_WA); bf16_t* H = (bf16_t*)(ws + WS_H); \
        bf16_t* Wbrg = (bf16_t*)(ws + WS_WB); bf16_t* Wbrf = Wbrg + (size_t)2048 * 2048; bf16_t* Wout2 = Wbrf + (size_t)2048 * 2048; \
        bf16_t *GQ = (bf16_t*)(ws + WS_GQ), *GK = (bf16_t*)(ws + WS_GK), *GV = (bf16_t*)(ws + WS_GV), *FQ = (bf16_t*)(ws + WS_FQ), *FK = (bf16_t*)(ws + WS_FK), *FV = (bf16_t*)(ws + WS_FV); \
        bf16_t *KT = (bf16_t*)(ws + WS_KT), *SG = (bf16_t*)(ws + WS_SG), *SF = (bf16_t*)(ws + WS_SF), *MGF = (bf16_t*)(ws + WS_MGF); \
        float *PS = (float*)(ws + WS_PS), *ACH = (float*)(ws + WS_ACH), *NB = (float*)(ws + WS_NB), *OSQ = (float*)(ws + WS_OSQ); \
        unsigned* ctl = (unsigned*)(ws + WS_CTL); float* RS1 = (float*)(ws + WS_RS); float* RS2 = RS1 + M; (void)RS1; (void)RS2; \
        LAS float* scr = (LAS float*)(lds + wid * 16640); \
        (void)lane; (void)gw; (void)NGW; (void)out; (void)XN; (void)WA; (void)H; (void)Wbrg; (void)Wbrf; (void)Wout2; (void)GQ; (void)GK; (void)GV; (void)FQ; (void)FK; (void)FV; (void)KT; (void)SG; (void)SF; (void)MGF; (void)PS; (void)ACH; (void)NB; (void)OSQ; (void)ctl; (void)scr;
#define IN(k) ((((PHMASK) >> (k)) & 1) && lo <= (k) && (k) < hi)
#define SEAM(k) do { if (lo <= (k) && (k) + 1 < hi) { xcd_barrier(xbar); } } while (0)
#define GEMM_UP(rs_) do { pg8::Gemm g{XN, WA, M, 2 * DFF, DM}; pg8::StaticOrder S; S.init(M, 2 * DFF, G, wg); pg8::EpiSwiGLU E{H, DFF, rs_}; \
        pg8::gemm_phase<pg8::EpiSwiGLU, pg8::StaticOrder, true, true>(lds, g, S, E, tid); } while (0)
#define GEMM_RES(BASE_BF, OUT_BF, A_, B_, K_, base_, out_, scale_, rs_) do { pg8::Gemm g{A_, B_, M, DM, K_}; pg8::StaticOrder S; S.init(M, DM, G, wg, 4); pg8::EpiResid<BASE_BF, OUT_BF> E{(const void*)(base_), (void*)(out_), scale_, rs_}; \
        pg8::gemm_phase<pg8::EpiResid<BASE_BF, OUT_BF>, pg8::StaticOrder, true, true>(lds, g, S, E, tid); } while (0)

__global__ void __launch_bounds__(NWAVES * 64, 2) fwd_mega(Args args) {
    extern __shared__ __attribute__((aligned(16))) unsigned char lds_raw[];
    LAS unsigned char* lds = (LAS unsigned char*)lds_raw;
    cg::grid_group grid = cg::this_grid();
    const int lo = args.ph_lo, hi = args.ph_hi;
    if (hi < 0) { __syncthreads(); grid.sync(); }
    { volatile LAS unsigned* misc = (volatile LAS unsigned*)(lds + LDS_MISC); if (threadIdx.x < 2) misc[threadIdx.x] = 0u; }
    __syncthreads();
    const XcdBarrier xbar = xcd_barrier_post((unsigned*)(GP(unsigned char, args.ws) + WS_CTL) + CW_BAR, (volatile LAS unsigned*)(lds + LDS_MISC));
    if (IN(0)) { PH_BEGIN
        int base = 0;
        if (wg == 0 && tid == 0) ctl[0] = 0u;
        for (int i = wg * 512 + tid; i < 2 * M; i += G * 512) RS1[i] = 0.f;
        conv_range(GP(const float, args.in[2]), DM, 2 * DFF, WA, DM, 2 * DFF, CM_SWIGLU, (const float*)nullptr, base, gw, NGW, scr, lane);
        conv_range(GP(const float, args.in[3]), DFF, DM, WA + (size_t)2 * DFF * DM, DFF, DM, CM_ID, (const float*)nullptr, base, gw, NGW, scr, lane);
        conv_range(GP(const float, args.in[12]), DM, DM, Wbrg, DM, DM, CM_ID, (const float*)nullptr, base, gw, NGW, scr, lane);
        conv_range(GP(const float, args.in[13]), DM, DM, Wbrf, DM, DM, CM_ID, (const float*)nullptr, base, gw, NGW, scr, lane);
        conv_range(GP(const float, args.in[15]), DM, DM, Wout2, DM, DM, CM_ID, (const float*)nullptr, base, gw, NGW, scr, lane);
        rms_rows_bf16(GP(const float, args.in[0]), GP(const float, args.in[1]), XN, gw, NGW, lane);
    }
    SEAM(0);
    if (IN(1)) { PH_BEGIN GEMM_UP((const float*)nullptr); }
    SEAM(1);
    if (IN(2)) { PH_BEGIN GEMM_RES(false, true, H, WA + (size_t)2 * DFF * DM, DFF, GP(const float, args.in[0]), XN, 0.5f, RS1); }
    SEAM(2);
    if (IN(3)) { PH_BEGIN
        int base = 0;
        conv_range(GP(const float, args.in[5]), DM, IN_W, WA, DM, IN_W, CM_WIN, GP(const float, args.in[4]), base, gw, NGW, scr, lane);
    }
    SEAM(3);
    if (IN(4)) {
        { PH_BEGIN small_proj(XN, WA + (size_t)18432 * DM, PS, RS1, lds, wg, G, wid, lane); }
        { PH_BEGIN
          pg8::Gemm g{XN, WA, M, 10240, DM}; pg8::StaticOrder S; S.init(M, 10240, G, wg);
          pg8::EpiQKV E{GQ, GK, GV, FQ, FK, FV, RS1};
          pg8::gemm_phase<pg8::EpiQKV, pg8::StaticOrder, true, true>(lds, g, S, E, tid); }
    }
    SEAM(4);
    if (IN(5)) { PH_BEGIN
        for (int item = wg; item < 2 * NCH * 4; item += G) gla_prep_item(item, PS, GP(const float, args.in[6]), GP(const float, args.in[7]), GK, KT, ACH, lds, tid);
        if (wg >= G - 32) fox_cumsum(PS, GP(const float, args.in[9]), NB, wg - (G - 32), lds, wid, lane);
        fox_qk_norm(FQ, FK, GP(const float, args.in[10]), GP(const float, args.in[11]), gw, NGW, lane);
    }
    SEAM(5);
    if (IN(6)) {
        if (blockIdx.x < N_GLA_UNITS) { PH_BEGIN gla_scan(wg, KT, GQ, GV, ACH, OSQ, lds, tid, wid, lane); __syncthreads(); }
        { PH_BEGIN
            LAS volatile int* nxt_s = (LAS volatile int*)(lds + fox::LDS_BYTES);
#define FOX_REF(i) ({ const int qb_ = 31 - ((i) >> 5), bh_ = (i) & 31; fox::BlockRef r_; r_.ro = (unsigned)(bh_ >> 4) * (unsigned)(T * DM) + (unsigned)(bh_ & 15) * 128u; r_.bh = bh_; r_.P0 = qb_ * 256; r_; })
            if (tid == 0) nxt_s[0] = (int)atomicAdd(ctl, 1u);
            __syncthreads();
            int cur_i = __builtin_amdgcn_readfirstlane(nxt_s[0]);
            if (cur_i < N_ATT_ITEMS) {
                const fox::Bases Bs{(fox::bf16*)FQ, (const fox::bf16*)FK, (const fox::bf16*)FV, NB};
                fox::BlockRef cur = FOX_REF(cur_i);
                fox::Seam Sm;
                fox::prime(Bs, cur, (char*)lds_raw, Sm, tid);
                for (;;) {
                    if (tid == 0) nxt_s[1] = (int)atomicAdd(ctl, 1u);
                    __syncthreads();
                    const int nxt_i = __builtin_amdgcn_readfirstlane(nxt_s[1]);
                    const fox::BlockRef nxt = nxt_i < N_ATT_ITEMS ? FOX_REF(nxt_i) : cur;
                    fox::block(Bs, cur, nxt, (char*)lds_raw, Sm, tid);
                    if (nxt_i >= N_ATT_ITEMS) break;
                    cur = nxt;
                }
            }
#undef FOX_REF
        }
    }
    SEAM(6);
    if (IN(7)) { PH_BEGIN
        pg8::Gemm g{XN, WA + (size_t)10240 * DM, M, 8192, DM}; pg8::StaticOrder S; S.init(M, 8192, G, wg);
        pg8::EpiGates E{GV, FQ, SG, SF, OSQ, GP(const float, args.in[8]), GP(const float, args.in[14]), RS1};
        pg8::gemm_phase<pg8::EpiGates, pg8::StaticOrder, true, true>(lds, g, S, E, tid);
    }
    SEAM(7);
    if (IN(8)) {
        { PH_BEGIN int base = 0;
          conv_range(GP(const float, args.in[17]), DM, 2 * DFF, WA, DM, 2 * DFF, CM_SWIGLU, GP(const float, args.in[16]), base, gw, NGW, scr, lane);
          conv_range(GP(const float, args.in[18]), DFF, DM, WA + (size_t)2 * DFF * DM, DFF, DM, CM_ID, (const float*)nullptr, base, gw, NGW, scr, lane);
          __syncthreads(); }
        { PH_BEGIN
          pg8::Gemm g{FQ, Wbrg, 2 * M, 2 * DM, DM};
          pg8::PairOrder S; S.init(M, DM, G, wg, 4);
          pg8::EpiGated E{SG, SF, MGF};
          pg8::gemm_phase<pg8::EpiGated, pg8::PairOrder, true, true>(lds, g, S, E, tid); }
    }
    SEAM(8);
    if (IN(9)) { PH_BEGIN GEMM_RES(true, true, MGF, Wout2, DM, XN, XN, 1.0f, RS2); }
    SEAM(9);
    if (IN(11)) { PH_BEGIN GEMM_UP((const float*)RS2); }
    SEAM(11);
    if (IN(12)) { PH_BEGIN GEMM_RES(true, false, H, WA + (size_t)2 * DFF * DM, DFF, XN, out, 0.5f, (float*)nullptr); }
    SEAM(12);
    if (IN(13)) { PH_BEGIN rms_rows_f32(out, GP(const float, args.in[19]), gw, NGW, lane); }
}

extern "C" void kernel_launch(void* const* d_in, const int* in_sizes, int n_in, void* d_out, int out_size, void* d_ws, size_t ws_size, hipStream_t stream) {
    static int grid = 0;
    if (grid == 0) {
        if (n_in != 20 || out_size != M * DM || ws_size < WS_END) { fprintf(stderr, "kernel_launch: unexpected shapes (n_in %d out %d ws %zu)\n", n_in, out_size, ws_size); grid = -1; return; }
        int dev = 0, cus = 0;
        (void)hipGetDevice(&dev); (void)hipDeviceGetAttribute(&cus, hipDeviceAttributeMultiprocessorCount, dev);
        (void)hipFuncSetAttribute((const void*)fwd_mega, hipFuncAttributeMaxDynamicSharedMemorySize, LDS_BYTES);
        int per_cu = 0;
        (void)hipOccupancyMaxActiveBlocksPerMultiprocessor(&per_cu, (const void*)fwd_mega, NWAVES * 64, LDS_BYTES);
        if (per_cu < 1) fprintf(stderr, "kernel_launch: occupancy query says %d blocks per CU\n", per_cu);
        (void)hipGetLastError();
        grid = cus > 0 ? cus : 256;
    }
    if (grid < 0) return;
    if (hipMemsetAsync((char*)d_ws + WS_CTL, 0, 65536, stream) != hipSuccess) { fprintf(stderr, "kernel_launch: memset of the control words failed\n"); return; }
    Args a{};
    for (int i = 0; i < 20; ++i) a.in[i] = (const float*)d_in[i];
    a.out = (float*)d_out; a.ws = (unsigned char*)d_ws;
#if MK_MULTI
    for (int ph = 0; ph < N_PHASES; ++ph) { a.ph_lo = ph; a.ph_hi = ph + 1; hipLaunchKernelGGL(fwd_mega, dim3(grid), dim3(NWAVES * 64), LDS_BYTES, stream, a); }
#else
    a.ph_lo = 0; a.ph_hi = N_PHASES;
    void* kargs[] = {&a};
    hipError_t e = hipLaunchCooperativeKernel((const void*)fwd_mega, dim3(grid), dim3(NWAVES * 64), kargs, LDS_BYTES, stream);
    if (e != hipSuccess) fprintf(stderr, "cooperative launch failed: %s (grid %d)\n", hipGetErrorString(e), grid);
#endif
}
```

```cpp
#include <hip/hip_runtime.h>
#include <hip/hip_bf16.h>
#include <hip/hip_cooperative_groups.h>
#include <cstdio>
#include <cstdint>
#ifndef MK_MULTI
#define MK_MULTI 0
#endif
namespace cg = cooperative_groups;
namespace pg8 {
#define PG8_LAS __attribute__((address_space(3)))
typedef unsigned short bf16_t;
typedef short bf16x8 __attribute__((ext_vector_type(8)));
typedef float f32x4 __attribute__((ext_vector_type(4)));
typedef unsigned u32x4 __attribute__((ext_vector_type(4)));
constexpr int BM = 256, BK = 64, HALF = 128, HTB = HALF * BK * 2  , STAGE_BYTES = 8 * HTB, NXCD = 8, WGM = 8;

__host__ __device__ __forceinline__ int lds_byte(int r, int c) { const int st = (r >> 4) * 2 + (c >> 5), rr = r & 15, cc = c & 31, ob = rr * 64 + cc * 2; return st * 1024 + (ob ^ (((ob >> 9) & 1) << 5)); }
__host__ __device__ __forceinline__ void stage_rc(int b, int& R, int& C) { const int st = b / 1024, sb = b % 1024, swz = sb ^ (((sb >> 9) & 1) << 5); R = (st >> 1) * 16 + swz / 64; C = (st & 1) * 32 + (swz % 64) / 2; }
__host__ __device__ __forceinline__ int perm32(int rho) { const int n = rho >> 4, i = rho & 15; return 8 * (i >> 2) + 4 * n + (i & 3); }

struct Unit { int pm, pn; };
struct Gemm { const bf16_t* A; const bf16_t* Bt; int M, N, K; };

struct StaticOrder {
    int nM, nN, nwg, G, c, wgm;
    __host__ __device__ void init(int M, int N, int G_, int c_, int wgm_ = WGM) { nM = M / BM; nN = N / BM; nwg = nM * nN; G = G_; c = c_; wgm = wgm_; }
    __host__ __device__ bool next(int i, Unit& u) const {
        const long L = (long)i * G + c; if (L >= nwg) return false;
        int wgid = (int)L; { const int q = nwg / NXCD, r = nwg % NXCD, xcd = wgid % NXCD, off = wgid / NXCD; wgid = (xcd < r ? xcd * (q + 1) : r * (q + 1) + (xcd - r) * q) + off; }
        const int nig = wgm * nN, gid = wgid / nig, fm = gid * wgm, gsz = (nM - fm) < wgm ? (nM - fm) : wgm;
        u.pm = fm + ((wgid % nig) % gsz); u.pn = (wgid % nig) / gsz; return true;
    }
    __device__ __forceinline__ void a_ready(const Unit&) const {}
    __device__ __forceinline__ void done(const Unit&) const {}
};

typedef float f32x2c_t __attribute__((ext_vector_type(2))); typedef __bf16 bf16x2c_t __attribute__((ext_vector_type(2)));
__device__ __forceinline__ unsigned cvt_pk_bf16(float lo, float hi) { const f32x2c_t v = {lo, hi}; const bf16x2c_t b = __builtin_convertvector(v, bf16x2c_t); return __builtin_bit_cast(unsigned, b); }
typedef float f32x2 __attribute__((ext_vector_type(2)));
__device__ __forceinline__ f32x2 gelu_pk(f32x2 v) {
    const f32x2 av = __builtin_elementwise_abs(v), d = av * 0.2316418882f + 1.0f;
    f32x2 t; t.x = __builtin_amdgcn_rcpf(d.x); t.y = __builtin_amdgcn_rcpf(d.y);
    f32x2 q = t * 0.5307027145f + (-0.7265760135f); q = q * t + 0.7107068705f; q = q * t + (-0.142248368f); q = q * t + 0.127414796f; q = q * t;
    const f32x2 s = (v * v) * (-0.72134752044f);
    f32x2 e; e.x = __builtin_amdgcn_exp2f(s.x); e.y = __builtin_amdgcn_exp2f(s.y);
    const f32x2 m = v * (q * e), r = v - m;
    f32x2 o; o.x = v.x < 0.f ? m.x : r.x; o.y = v.y < 0.f ? m.y : r.y; return o;
}

template <int ACT  > struct EpiBf16 {
    static constexpr bool PERM = true, AFTER_DRAIN = false; static_assert(ACT == 0 || ACT == 1, "EpiBf16: ACT is 0 (none) or 1 (gelu_pk)");
    bf16_t* O; int ldc; const float* bias; int split_cols; size_t split_stride; float scale0;
    __device__ __forceinline__ void operator()(const f32x4 (&acc)[2][2][4][2], const Unit& u, int wr, int wc, int fr, int fq) const {
        const int row0 = u.pm * BM + wr * 64 + fr; int colt = u.pn * BM; bf16_t* base = O;
        float sc = 1.f; if (split_cols) { const int t = colt / split_cols; base += (size_t)t * split_stride; colt -= t * split_cols; if (t == 0) sc = scale0; }
        const int col0 = colt + wc * 32 + 8 * fq, bcol0 = u.pn * BM + wc * 32 + 8 * fq;
        f32x4 bv[2][2];
#pragma unroll
        for (int bj = 0; bj < 2; ++bj)
#pragma unroll
            for (int n = 0; n < 2; ++n) bv[bj][n] = bias ? *(const f32x4*)(bias + bcol0 + bj * HALF + 4 * n) : (f32x4){0.f, 0.f, 0.f, 0.f};
#pragma unroll
        for (int ai = 0; ai < 2; ++ai)
#pragma unroll
            for (int m = 0; m < 4; ++m) { bf16_t* rowp = base + (size_t)(row0 + ai * HALF + m * 16) * ldc + col0;
#pragma unroll
                for (int bj = 0; bj < 2; ++bj) { f32x4 v0 = acc[ai][bj][m][0] + bv[bj][0], v1 = acc[ai][bj][m][1] + bv[bj][1];
                    if (ACT == 1) { f32x2 a = gelu_pk((f32x2){v0[0], v0[1]}), b = gelu_pk((f32x2){v0[2], v0[3]}), c = gelu_pk((f32x2){v1[0], v1[1]}), d = gelu_pk((f32x2){v1[2], v1[3]});
                        v0 = (f32x4){a.x, a.y, b.x, b.y}; v1 = (f32x4){c.x, c.y, d.x, d.y}; }
                    v0 = v0 * sc; v1 = v1 * sc; u32x4 w; w.x = cvt_pk_bf16(v0[0], v0[1]); w.y = cvt_pk_bf16(v0[2], v0[3]); w.z = cvt_pk_bf16(v1[0], v1[1]); w.w = cvt_pk_bf16(v1[2], v1[3]);
                    *(u32x4*)(rowp + bj * HALF) = w; } }
    }
};
__device__ __forceinline__ float sigmoid_f(float x) { return __builtin_amdgcn_rcpf(1.0f + __builtin_amdgcn_exp2f(-1.4426950408889634f * x)); }
__device__ __forceinline__ float silu_f(float x) { return x * sigmoid_f(x); }
__device__ __forceinline__ float bf_lo(unsigned w) { return __uint_as_float(w << 16); }
__device__ __forceinline__ float bf_hi(unsigned w) { return __uint_as_float(w & 0xffff0000u); }
typedef unsigned u32x2 __attribute__((ext_vector_type(2)));

struct EpiSwiGLU {
    static constexpr bool PERM = true, AFTER_DRAIN = false;
    bf16_t* H; int ldh; const float* rs;
    __device__ __forceinline__ void operator()(const f32x4 (&acc)[2][2][4][2], const Unit& u, int wr, int wc, int fr, int fq) const {
        const int row0 = u.pm * BM + wr * 64 + fr, col0 = u.pn * HALF + wc * 32 + 8 * fq;
#pragma unroll
        for (int ai = 0; ai < 2; ++ai)
#pragma unroll
            for (int m = 0; m < 4; ++m) {
                bf16_t* rowp = H + (size_t)(row0 + ai * HALF + m * 16) * ldh + col0;
                const float rstd = rs ? __builtin_amdgcn_rsqf(rs[row0 + ai * HALF + m * 16] * (1.0f / 2048.0f) + 1e-6f) : 1.0f;
                const f32x4 g0 = acc[ai][0][m][0] * rstd, g1 = acc[ai][0][m][1] * rstd, u0 = acc[ai][1][m][0] * rstd, u1 = acc[ai][1][m][1] * rstd;
                u32x4 w;
                w.x = cvt_pk_bf16(silu_f(g0[0]) * u0[0], silu_f(g0[1]) * u0[1]); w.y = cvt_pk_bf16(silu_f(g0[2]) * u0[2], silu_f(g0[3]) * u0[3]);
                w.z = cvt_pk_bf16(silu_f(g1[0]) * u1[0], silu_f(g1[1]) * u1[1]); w.w = cvt_pk_bf16(silu_f(g1[2]) * u1[2], silu_f(g1[3]) * u1[3]);
                __builtin_nontemporal_store(w, (u32x4*)rowp);
            }
    }
};
template <bool BASE_BF, bool OUT_BF> struct EpiResid {
    static constexpr bool PERM = true, AFTER_DRAIN = false;
    const void* base; void* out; float scale; float* rs;
    __device__ __forceinline__ void operator()(const f32x4 (&acc)[2][2][4][2], const Unit& u, int wr, int wc, int fr, int fq) const {
        const int row0 = u.pm * BM + wr * 64 + fr, col0 = u.pn * BM + wc * 32 + 8 * fq;
#pragma unroll
        for (int ai = 0; ai < 2; ++ai) {
            f32x4 bv[4][2][2];
#pragma unroll
            for (int m = 0; m < 4; ++m)
#pragma unroll
                for (int bj = 0; bj < 2; ++bj) { const size_t off = (size_t)(row0 + ai * HALF + m * 16) * 2048 + col0 + bj * HALF;
                    if (BASE_BF) { const u32x4 w = *(const u32x4*)((const bf16_t*)base + off); bv[m][bj][0] = (f32x4){bf_lo(w.x), bf_hi(w.x), bf_lo(w.y), bf_hi(w.y)}; bv[m][bj][1] = (f32x4){bf_lo(w.z), bf_hi(w.z), bf_lo(w.w), bf_hi(w.w)}; }
                    else { const float* bp = (const float*)base + off; bv[m][bj][0] = __builtin_nontemporal_load((const f32x4*)bp); bv[m][bj][1] = __builtin_nontemporal_load((const f32x4*)(bp + 4)); } }
            asm volatile("" ::: "memory");
#pragma unroll
            for (int m = 0; m < 4; ++m) { const int row = row0 + ai * HALF + m * 16; float ss = 0.f;
#pragma unroll
                for (int bj = 0; bj < 2; ++bj) { const size_t off = (size_t)row * 2048 + col0 + bj * HALF;
                    const f32x4 y0 = bv[m][bj][0] + acc[ai][bj][m][0] * scale, y1 = bv[m][bj][1] + acc[ai][bj][m][1] * scale;
                    ss += ((y0[0] * y0[0] + y0[1] * y0[1]) + (y0[2] * y0[2] + y0[3] * y0[3])) + ((y1[0] * y1[0] + y1[1] * y1[1]) + (y1[2] * y1[2] + y1[3] * y1[3]));
                    if (OUT_BF) { u32x4 w; w.x = cvt_pk_bf16(y0[0], y0[1]); w.y = cvt_pk_bf16(y0[2], y0[3]); w.z = cvt_pk_bf16(y1[0], y1[1]); w.w = cvt_pk_bf16(y1[2], y1[3]); *(u32x4*)((bf16_t*)out + off) = w; }
                    else { float* op = (float*)out + off; *(f32x4*)op = y0; *(f32x4*)(op + 4) = y1; } }
                if (rs) { ss += __shfl_xor(ss, 16); ss += __shfl_xor(ss, 32); if (fq == 0) atomicAdd(rs + row, ss); } }
            asm volatile("" ::: "memory"); }
    }
};
struct EpiQKV {
    static constexpr bool PERM = true, AFTER_DRAIN = false;
    bf16_t *gq, *gk, *gv, *fq_, *fk, *fv; const float* rs;
    __device__ __forceinline__ void operator()(const f32x4 (&acc)[2][2][4][2], const Unit& u, int wr, int wc, int fr, int fq) const {
        bf16_t* base; int ldc, colt; const int pn = u.pn;
        if (pn < 4) { base = gq; ldc = 1024; colt = pn * 256; } else if (pn < 8) { base = gk; ldc = 1024; colt = (pn - 4) * 256; }
        else if (pn < 16) { base = gv; ldc = 2048; colt = (pn - 8) * 256; } else if (pn < 24) { base = fq_; ldc = 2048; colt = (pn - 16) * 256; }
        else if (pn < 32) { base = fk; ldc = 2048; colt = (pn - 24) * 256; } else { base = fv; ldc = 2048; colt = (pn - 32) * 256; }
        const int row0 = u.pm * BM + wr * 64 + fr, col0 = colt + wc * 32 + 8 * fq;
#pragma unroll
        for (int ai = 0; ai < 2; ++ai)
#pragma unroll
            for (int m = 0; m < 4; ++m) { bf16_t* rowp = base + (size_t)(row0 + ai * HALF + m * 16) * ldc + col0;
                const float rstd = __builtin_amdgcn_rsqf(rs[row0 + ai * HALF + m * 16] * (1.0f / 2048.0f) + 1e-6f);
#pragma unroll
                for (int bj = 0; bj < 2; ++bj) { const f32x4 v0 = acc[ai][bj][m][0] * rstd, v1 = acc[ai][bj][m][1] * rstd;
                    u32x4 w; w.x = cvt_pk_bf16(v0[0], v0[1]); w.y = cvt_pk_bf16(v0[2], v0[3]); w.z = cvt_pk_bf16(v1[0], v1[1]); w.w = cvt_pk_bf16(v1[2], v1[3]);
                    __builtin_nontemporal_store(w, (u32x4*)(rowp + bj * HALF)); } }
    }
};
struct EpiGates {
    static constexpr bool PERM = true, AFTER_DRAIN = false;
    bf16_t *agla, *afox, *sg, *sf; const float* osq; const float* gon; const float* bm; const float* rsx;
    __device__ __forceinline__ void operator()(const f32x4 (&acc)[2][2][4][2], const Unit& u, int wr, int wc, int fr, int fq) const {
        const int pn = u.pn, kind = pn >> 3, colt = (pn & 7) * 256;
        const int row0 = u.pm * BM + wr * 64 + fr, col0 = colt + wc * 32 + 8 * fq;
        bf16_t* base = kind == 0 ? agla : kind == 1 ? afox : kind == 2 ? sg : sf;
        f32x4 cv[2][2];
#pragma unroll
        for (int bj = 0; bj < 2; ++bj)
#pragma unroll
            for (int n = 0; n < 2; ++n) {
                if (kind == 0) cv[bj][n] = *(const f32x4*)(gon + col0 + bj * HALF + 4 * n);
                else if (kind >= 2) cv[bj][n] = *(const f32x4*)(bm + (kind - 2) * 2048 + col0 + bj * HALF + 4 * n);
                else cv[bj][n] = (f32x4){0.f, 0.f, 0.f, 0.f}; }
#pragma unroll
        for (int ai = 0; ai < 2; ++ai) {
            u32x4 ov[4][2]; float rstd[4], rso[4];
#pragma unroll
            for (int m = 0; m < 4; ++m) { const int row = row0 + ai * HALF + m * 16; rstd[m] = rsx[row]; rso[m] = 1.f;
                if (kind == 0) { const f32x4* pp = (const f32x4*)(osq + (size_t)row * 128 + (pn >> 1) * 32 + fq * 8); const f32x4 p = pp[0] + pp[1]; rso[m] = (p[0] + p[1]) + (p[2] + p[3]); }
#pragma unroll
                for (int bj = 0; bj < 2; ++bj) ov[m][bj] = kind <= 1 ? *(const u32x4*)(base + (size_t)row * 2048 + col0 + bj * HALF) : (u32x4){0u, 0u, 0u, 0u}; }
            asm volatile("" ::: "memory");
#pragma unroll
            for (int m = 0; m < 4; ++m) { const int row = row0 + ai * HALF + m * 16; bf16_t* rowp = base + (size_t)row * 2048 + col0;
                const float rs_x = __builtin_amdgcn_rsqf(rstd[m] * (1.0f / 2048.0f) + 1e-6f); float rs = 1.f;
                if (kind == 0) { float t = rso[m]; t += __shfl_xor(t, 16); t += __shfl_xor(t, 32); rs = __builtin_amdgcn_rsqf(t * (1.0f / 512.0f) + 1e-6f); }
#pragma unroll
                for (int bj = 0; bj < 2; ++bj) { const f32x4 v0 = acc[ai][bj][m][0] * rs_x, v1 = acc[ai][bj][m][1] * rs_x; float r[8];
                    if (kind <= 1) { const u32x4 o = ov[m][bj];
                        const float ovv[8] = {bf_lo(o.x), bf_hi(o.x), bf_lo(o.y), bf_hi(o.y), bf_lo(o.z), bf_hi(o.z), bf_lo(o.w), bf_hi(o.w)};
#pragma unroll
                        for (int i = 0; i < 4; ++i) {
                            if (kind == 0) { r[i] = ovv[i] * rs * cv[bj][0][i] * silu_f(v0[i]); r[4 + i] = ovv[4 + i] * rs * cv[bj][1][i] * silu_f(v1[i]); }
                            else { r[i] = ovv[i] * sigmoid_f(v0[i]); r[4 + i] = ovv[4 + i] * sigmoid_f(v1[i]); } }
                    } else {
#pragma unroll
                        for (int i = 0; i < 4; ++i) { r[i] = sigmoid_f(v0[i] + cv[bj][0][i]); r[4 + i] = sigmoid_f(v1[i] + cv[bj][1][i]); } }
                    u32x4 w; w.x = cvt_pk_bf16(r[0], r[1]); w.y = cvt_pk_bf16(r[2], r[3]); w.z = cvt_pk_bf16(r[4], r[5]); w.w = cvt_pk_bf16(r[6], r[7]);
                    __builtin_nontemporal_store(w, (u32x4*)(rowp + bj * HALF)); } }
            asm volatile("" ::: "memory"); }
    }
};
struct EpiGated {
    static constexpr bool PERM = true, AFTER_DRAIN = false;
    const bf16_t* sg; const bf16_t* sf; bf16_t* mg;
    __device__ __forceinline__ void operator()(const f32x4 (&acc)[2][2][4][2], const Unit& u, int wr, int wc, int fr, int fq) const {
        const bool fox = u.pn >= 8; const int pm = u.pm & 63, pn = u.pn & 7; const bf16_t* gate = fox ? sf : sg;
        const int row0 = pm * BM + wr * 64 + fr, col0 = pn * BM + wc * 32 + 8 * fq;
#pragma unroll
        for (int ai = 0; ai < 2; ++ai) {
            u32x4 gv[4][2], pv[4][2];
#pragma unroll
            for (int m = 0; m < 4; ++m)
#pragma unroll
                for (int bj = 0; bj < 2; ++bj) { const size_t off = (size_t)(row0 + ai * HALF + m * 16) * 2048 + col0 + bj * HALF;
                    gv[m][bj] = *(const u32x4*)(gate + off); pv[m][bj] = fox ? *(const u32x4*)(mg + off) : (u32x4){0u, 0u, 0u, 0u}; }
            asm volatile("" ::: "memory");
#pragma unroll
            for (int m = 0; m < 4; ++m)
#pragma unroll
                for (int bj = 0; bj < 2; ++bj) { const f32x4 v0 = acc[ai][bj][m][0], v1 = acc[ai][bj][m][1]; const size_t off = (size_t)(row0 + ai * HALF + m * 16) * 2048 + col0 + bj * HALF;
                    const u32x4 g = gv[m][bj], p = pv[m][bj];
                    float r[8] = {bf_lo(g.x) * v0[0], bf_hi(g.x) * v0[1], bf_lo(g.y) * v0[2], bf_hi(g.y) * v0[3], bf_lo(g.z) * v1[0], bf_hi(g.z) * v1[1], bf_lo(g.w) * v1[2], bf_hi(g.w) * v1[3]};
                    r[0] += bf_lo(p.x); r[1] += bf_hi(p.x); r[2] += bf_lo(p.y); r[3] += bf_hi(p.y); r[4] += bf_lo(p.z); r[5] += bf_hi(p.z); r[6] += bf_lo(p.w); r[7] += bf_hi(p.w);
                    u32x4 w; w.x = cvt_pk_bf16(r[0], r[1]); w.y = cvt_pk_bf16(r[2], r[3]); w.z = cvt_pk_bf16(r[4], r[5]); w.w = cvt_pk_bf16(r[6], r[7]);
                    *(u32x4*)(mg + off) = w; }
            asm volatile("" ::: "memory"); }
    }
};
struct PairOrder {
    StaticOrder so;
    __host__ __device__ void init(int M, int N, int G_, int c_, int wgm_) { so.init(M, N, G_, c_, wgm_); }
    __host__ __device__ bool next(int i, Unit& u) const { Unit b; if (!so.next(i >> 1, b)) return false; if (i & 1) { u.pm = b.pm; u.pn = b.pn + 8; } else { u.pm = b.pm + 64; u.pn = b.pn; } return true; }
    __device__ __forceinline__ void a_ready(const Unit&) const {}
    __device__ __forceinline__ void done(const Unit&) const {}
};
template <class Epi, class Sched, bool ALIGN_EPI = false, bool SP2 = false>
__device__ __forceinline__ void gemm_phase(PG8_LAS unsigned char* lds, const Gemm g, const Sched& S, const Epi& E, const int tid) {
    const int wid = __builtin_amdgcn_readfirstlane(tid >> 6), lane = tid & 63, wr = wid >> 2, wc = wid & 3, fr = lane & 15, fq = lane >> 4;
    const int K = g.K, nt = K / BK;
    unsigned voffA[2], voffB[2];
#pragma unroll
    for (int i = 0; i < 2; ++i) { int R, C; stage_rc(tid * 16 + i * 8192, R, C); const int Rb = Epi::PERM ? ((R & ~31) + perm32(R & 31)) : R;
        voffA[i] = (unsigned)(R * K + C) * 2u; voffB[i] = (unsigned)(Rb * K + C) * 2u; }
    const size_t kstep = (size_t)(BK * 2);
    const size_t hstep = (size_t)HALF * K * 2;
    const size_t tstep = 2 * hstep;
    const unsigned ldsw = (unsigned)wid * 1024u;
    const int aoff = lds_byte(wr * 64 + fr, fq * 8), boff = lds_byte(wc * 32 + fr, fq * 8);
#define PG8_SA(b, h) (((b) * 2 + (h)) * HTB)
#define PG8_SB(b, h) ((4 + (b) * 2 + (h)) * HTB)
#define PG8_STAGE(bufoff, gbase, voff) do { _Pragma("unroll") for (int _i = 0; _i < 2; ++_i) \
        __builtin_amdgcn_global_load_lds((const unsigned*)((const char*)(gbase) + (voff)[_i]), (PG8_LAS unsigned*)(lds + (bufoff) + ldsw + _i * 8192), 16, 0, 0); } while (0)
#define PG8_LDA(dst, b, h) do { _Pragma("unroll") for (int m = 0; m < 4; ++m) _Pragma("unroll") for (int k = 0; k < 2; ++k) dst[m][k] = *(const PG8_LAS bf16x8*)(lds + PG8_SA(b, h) + aoff + m * 2048 + k * 1024); } while (0)
#define PG8_LDB(dst, b, h) do { _Pragma("unroll") for (int n = 0; n < 2; ++n) _Pragma("unroll") for (int k = 0; k < 2; ++k) dst[n][k] = *(const PG8_LAS bf16x8*)(lds + PG8_SB(b, h) + boff + n * 2048 + k * 1024); } while (0)
#define PG8_MMA(ai, bj, At, Bt) do { __builtin_amdgcn_s_setprio(1); _Pragma("unroll") for (int m = 0; m < 4; ++m) _Pragma("unroll") for (int n = 0; n < 2; ++n) _Pragma("unroll") for (int k = 0; k < 2; ++k) \
        acc[ai][bj][m][n] = __builtin_amdgcn_mfma_f32_16x16x32_bf16(Bt[n][k], At[m][k], acc[ai][bj][m][n], 0, 0, 0); __builtin_amdgcn_s_setprio(0); } while (0)
#define PG8_WAIT_V(n) asm volatile("s_waitcnt vmcnt(" #n ")" ::: "memory")
#define PG8_WAIT_L(n) asm volatile("s_waitcnt lgkmcnt(" #n ")" ::: "memory")
#define PG8_BAR __builtin_amdgcn_s_barrier()
#define PG8_SCHED __builtin_amdgcn_sched_barrier(0)
    Unit cur, nxt; int ui = 0;
    if (!S.next(0, cur)) return;
    f32x4 acc[2][2][4][2];
#pragma unroll
    for (int a = 0; a < 2; ++a)
#pragma unroll
        for (int b = 0; b < 2; ++b)
#pragma unroll
            for (int m = 0; m < 4; ++m)
#pragma unroll
                for (int n = 0; n < 2; ++n) acc[a][b][m][n] = (f32x4){0.f, 0.f, 0.f, 0.f};
    bf16x8 At[4][2], B0[2][2], B1[2][2];
    const char* cA = (const char*)g.A + (size_t)cur.pm * tstep; const char* cB = (const char*)g.Bt + (size_t)cur.pn * tstep;
    S.a_ready(cur);
    if constexpr (SP2) {
        PG8_STAGE(PG8_SB(0, 0), cB, voffB); PG8_STAGE(PG8_SB(0, 1), cB + hstep, voffB); PG8_STAGE(PG8_SA(0, 0), cA, voffA); PG8_STAGE(PG8_SA(0, 1), cA + hstep, voffA);
        if (wr == 1) PG8_BAR;
        PG8_WAIT_V(2); PG8_BAR;
        PG8_STAGE(PG8_SB(1, 0), cB + kstep, voffB); PG8_STAGE(PG8_SA(1, 0), cA + kstep, voffA); PG8_STAGE(PG8_SB(1, 1), cB + hstep + kstep, voffB);
        PG8_WAIT_V(6); PG8_BAR;
    } else {
        PG8_STAGE(PG8_SB(0, 0), cB, voffB); PG8_STAGE(PG8_SA(0, 0), cA, voffA); PG8_STAGE(PG8_SB(0, 1), cB + hstep, voffB); PG8_STAGE(PG8_SA(0, 1), cA + hstep, voffA);
        if (wr == 1) PG8_BAR;
        PG8_WAIT_V(4); PG8_BAR;
        PG8_STAGE(PG8_SB(1, 0), cB + kstep, voffB); PG8_STAGE(PG8_SA(1, 0), cA + kstep, voffA); PG8_STAGE(PG8_SB(1, 1), cB + hstep + kstep, voffB);
        PG8_WAIT_V(6); PG8_BAR;
    }
    for (;;) {
        const bool has_next = S.next(ui + 1, nxt);
        const char* nA = has_next ? (const char*)g.A + (size_t)nxt.pm * tstep : cA; const char* nB = has_next ? (const char*)g.Bt + (size_t)nxt.pn * tstep : cB;
        for (int t = 0; t < nt; t += 2) {
            const bool last = (t == nt - 2);
            const char* a1 = cA + (size_t)(t + 1) * kstep;
            const char* a2 = last ? nA : cA + (size_t)(t + 2) * kstep; const char* b2 = last ? nB : cB + (size_t)(t + 2) * kstep;
            const char* a3 = a2 + kstep; const char* b3 = b2 + kstep;
            if (last && has_next) S.a_ready(nxt);
            if constexpr (SP2) {
            PG8_LDB(B0, 0, 0); PG8_LDB(B1, 0, 1); PG8_SCHED; PG8_LDA(At, 0, 0); PG8_STAGE(PG8_SA(1, 1), a1 + hstep, voffA);
            PG8_WAIT_V(8); PG8_WAIT_L(0); PG8_BAR; PG8_MMA(0, 0, At, B0); PG8_MMA(0, 1, At, B1); PG8_BAR; PG8_SCHED;
            PG8_LDA(At, 0, 1); PG8_STAGE(PG8_SB(0, 0), b2, voffB); PG8_STAGE(PG8_SB(0, 1), b2 + hstep, voffB); PG8_STAGE(PG8_SA(0, 0), a2, voffA);
            PG8_WAIT_V(8); PG8_WAIT_L(0); PG8_BAR; PG8_MMA(1, 0, At, B0); PG8_MMA(1, 1, At, B1); PG8_BAR; PG8_SCHED;
            PG8_LDB(B0, 1, 0); PG8_LDB(B1, 1, 1); PG8_SCHED; PG8_LDA(At, 1, 0); PG8_STAGE(PG8_SA(0, 1), a2 + hstep, voffA);
            PG8_WAIT_V(8); PG8_WAIT_L(0); PG8_BAR; PG8_MMA(0, 0, At, B0); PG8_MMA(0, 1, At, B1); PG8_BAR; PG8_SCHED;
            PG8_LDA(At, 1, 1); PG8_STAGE(PG8_SB(1, 0), b3, voffB); PG8_STAGE(PG8_SB(1, 1), b3 + hstep, voffB); PG8_STAGE(PG8_SA(1, 0), a3, voffA);
            PG8_WAIT_V(8); PG8_WAIT_L(0); PG8_BAR; PG8_MMA(1, 0, At, B0); PG8_MMA(1, 1, At, B1); PG8_BAR; PG8_SCHED;
            } else {
            PG8_LDB(B0, 0, 0); PG8_SCHED; PG8_LDA(At, 0, 0); PG8_STAGE(PG8_SA(1, 1), a1 + hstep, voffA);
            PG8_WAIT_L(8); PG8_BAR; PG8_WAIT_L(0); PG8_MMA(0, 0, At, B0); PG8_BAR; PG8_SCHED;
            PG8_LDB(B1, 0, 1); PG8_STAGE(PG8_SB(0, 0), b2, voffB);
            PG8_BAR; PG8_WAIT_L(0); PG8_MMA(0, 1, At, B1); PG8_BAR;
            PG8_LDA(At, 0, 1); PG8_STAGE(PG8_SA(0, 0), a2, voffA);
            PG8_BAR; PG8_WAIT_L(0); PG8_MMA(1, 0, At, B0); PG8_BAR; PG8_SCHED;
            PG8_STAGE(PG8_SB(0, 1), b2 + hstep, voffB);
            PG8_WAIT_V(6); PG8_BAR; PG8_MMA(1, 1, At, B1); PG8_BAR;
            PG8_LDB(B0, 1, 0); PG8_SCHED; PG8_LDA(At, 1, 0); PG8_STAGE(PG8_SA(0, 1), a2 + hstep, voffA);
            PG8_WAIT_L(8); PG8_BAR; PG8_WAIT_L(0); PG8_MMA(0, 0, At, B0); PG8_BAR; PG8_SCHED;
            PG8_LDB(B1, 1, 1); PG8_STAGE(PG8_SB(1, 0), b3, voffB);
            PG8_BAR; PG8_WAIT_L(0); PG8_MMA(0, 1, At, B1); PG8_BAR;
            PG8_LDA(At, 1, 1); PG8_STAGE(PG8_SA(1, 0), a3, voffA);
            PG8_BAR; PG8_WAIT_L(0); PG8_MMA(1, 0, At, B0); PG8_BAR; PG8_SCHED;
            PG8_STAGE(PG8_SB(1, 1), b3 + hstep, voffB);
            PG8_WAIT_V(6); PG8_BAR; PG8_MMA(1, 1, At, B1); PG8_BAR;
            }
        }
        if constexpr (ALIGN_EPI) { if (wr == 0) PG8_BAR; }
        if constexpr (!Epi::AFTER_DRAIN) { E(acc, cur, wr, wc, fr, fq); S.done(cur); }
        if (!has_next) break;
#pragma unroll
        for (int a = 0; a < 2; ++a)
#pragma unroll
            for (int b = 0; b < 2; ++b)
#pragma unroll
                for (int m = 0; m < 4; ++m)
#pragma unroll
                    for (int n = 0; n < 2; ++n) acc[a][b][m][n] = (f32x4){0.f, 0.f, 0.f, 0.f};
        cur = nxt; cA = nA; cB = nB; ++ui;
        if constexpr (ALIGN_EPI) { if (wr == 1) PG8_BAR; }
    }
    PG8_WAIT_V(0);
    if constexpr (!ALIGN_EPI) { if (wr == 0) PG8_BAR; }
    PG8_BAR;
    if constexpr (Epi::AFTER_DRAIN) { E.fused(acc, cur, wr, wc, fr, fq, lds, wid, lane); S.done(cur); }
#undef PG8_SA
#undef PG8_SB
#undef PG8_STAGE
#undef PG8_LDA
#undef PG8_LDB
#undef PG8_MMA
#undef PG8_WAIT_V
#undef PG8_WAIT_L
#undef PG8_BAR
#undef PG8_SCHED
}
}

namespace fox {
constexpr int D = 128, PITCH = 2048, NW = 8, QBLK = 32, KVBLK = 64, QB = NW * QBLK;
constexpr int SHM_V = KVBLK * D * 2, SHM_K = KVBLK * D * 2;
constexpr int OFF_WS = 2 * SHM_V + 2 * SHM_K, OFF_BIAS = OFF_WS + NW * 64 * 4, LDS_BYTES = OFF_BIAS + 512;
constexpr float THR = 8.f;
using bf16 = __hip_bfloat16;
typedef short bf16x8 __attribute__((ext_vector_type(8)));
typedef short s16x4 __attribute__((ext_vector_type(4)));
typedef float f32x16 __attribute__((ext_vector_type(16)));
typedef float f32x4 __attribute__((ext_vector_type(4)));
typedef unsigned u32x4 __attribute__((ext_vector_type(4)));
#define KSWZ(row, colB) ((row) * 256 + ((colB) ^ (((row) & 7) << 4)))
#define SBAR() __builtin_amdgcn_sched_barrier(0)
__device__ __forceinline__ int v_st(int k, int c) { const int kk = (k & ~0xC) | ((k & 4) << 1) | ((k & 8) >> 1); return ((kk >> 3) * 4 + (c >> 5)) * 512 + ((kk & 7) * 32 + (c & 31)) * 2; }
__device__ __forceinline__ int v_rd_base(int lane) { return ((lane & 3) << 3) | (((lane >> 2) & 3) << 6) | (((lane >> 4) & 1) << 5) | (((lane >> 5) & 1) << 8); }
constexpr int v_rd_off(int d0, int ks, int half) { return d0 * 512 + ks * 4096 + half * 2048; }
__device__ __forceinline__ int crow(int r, int hi) { return (r & 3) + 8 * (r >> 2) + 4 * hi; }
__device__ __forceinline__ unsigned cvtpk(float lo, float hi) { unsigned r; asm volatile("v_cvt_pk_bf16_f32 %0, %1, %2" : "=v"(r) : "v"(lo), "v"(hi)); return r; }
__device__ __forceinline__ bf16x8 load8(const bf16* p) { return *reinterpret_cast<const bf16x8*>(p); }
__device__ __forceinline__ void mask_tile(f32x16& p0, f32x16& p1, int dq, unsigned W) {
    const float NEG = -__builtin_inff();
#pragma unroll
    for (int r = 0; r < 16; ++r) { const int c = (r & 3) + 8 * (r >> 2);
        if (c > dq) p0[r] = NEG;
        if (c + 32 > dq) p1[r] = NEG; }
}
__device__ __forceinline__ void add_bias(f32x16& p0, f32x16& p1, const float* bl) {
#pragma unroll
    for (int j = 0; j < 4; ++j) { const f32x4 b0 = *(const f32x4*)(bl + 8 * j), b1 = *(const f32x4*)(bl + 32 + 8 * j);
#pragma unroll
        for (int i = 0; i < 4; ++i) { p0[4 * j + i] += b0[i]; p1[4 * j + i] += b1[i]; } }
}
__device__ __forceinline__ void partialSM(f32x16& p0, f32x16& p1, float& m_reg, float& mn, float& alpha) {
    float pmax = p0[0]; for (int r = 1; r < 16; ++r) pmax = fmaxf(pmax, p0[r]); for (int r = 0; r < 16; ++r) pmax = fmaxf(pmax, p1[r]);
    { auto rr = __builtin_amdgcn_permlane32_swap(__float_as_uint(pmax), __float_as_uint(pmax), false, false);
      pmax = fmaxf(__uint_as_float(rr[0]), __uint_as_float(rr[1])); }
    if (__builtin_expect(__all((pmax - m_reg) <= THR), 1)) { mn = m_reg; alpha = 1.f; }
    else { mn = fmaxf(m_reg, pmax); alpha = __builtin_amdgcn_exp2f(m_reg - mn); m_reg = mn; }
    for (int r = 0; r < 16; ++r) p0[r] = p0[r] - mn; for (int r = 0; r < 16; ++r) p1[r] = p1[r] - mn;
    for (int r = 0; r < 16; ++r) p0[r] = __builtin_amdgcn_exp2f(p0[r]);
}
__device__ __forceinline__ void finishSM(f32x16& p0, f32x16& p1, float alpha, float& l_reg, bf16x8& pa0, bf16x8& pa1, bf16x8& pa2, bf16x8& pa3) {
    for (int r = 0; r < 16; ++r) p1[r] = __builtin_amdgcn_exp2f(p1[r]);
    float ps = 0; for (int r = 0; r < 16; ++r) ps += p0[r]; for (int r = 0; r < 16; ++r) ps += p1[r];
    { auto rr = __builtin_amdgcn_permlane32_swap(__float_as_uint(ps), __float_as_uint(ps), false, false);
      ps = __uint_as_float(rr[0]) + __uint_as_float(rr[1]); }
    l_reg = l_reg * alpha + ps;
#define PK4(P, B_, OUT) do { unsigned a0 = cvtpk(P[B_+0], P[B_+1]), a1 = cvtpk(P[B_+2], P[B_+3]);                          \
        unsigned b0 = cvtpk(P[B_+4], P[B_+5]), b1 = cvtpk(P[B_+6], P[B_+7]);                                             \
        auto r0 = __builtin_amdgcn_permlane32_swap(a0, b0, false, false); auto r1 = __builtin_amdgcn_permlane32_swap(a1, b1, false, false); \
        u32x4 w = {r0[0], r1[0], r0[1], r1[1]}; OUT = *reinterpret_cast<bf16x8*>(&w); } while (0)
    PK4(p0, 0, pa0); PK4(p0, 8, pa1); PK4(p1, 0, pa2); PK4(p1, 8, pa3);
#undef PK4
}
template <int KB>
__device__ __forceinline__ void qkt(f32x16& p0, f32x16& p1, const char* K_lds, const float* B_lds, int r32, int hi, const bf16x8* qr) {
    { const float* bl = B_lds + KB * 64 + 4 * hi;
#pragma unroll
      for (int j = 0; j < 4; ++j) { const f32x4 b0 = *(const f32x4*)(bl + 8 * j), b1 = *(const f32x4*)(bl + 32 + 8 * j);
#pragma unroll
          for (int i = 0; i < 4; ++i) { p0[4 * j + i] = b0[i]; p1[4 * j + i] = b1[i]; } } }
    const char* kb[4];
#pragma unroll
    for (int dd = 0; dd < 4; ++dd) kb[dd] = K_lds + KB * SHM_K + KSWZ(r32, (dd * 16 + hi * 8) * 2);
#pragma unroll
    for (int d0 = 0; d0 < 8; ++d0) { const char* a = kb[d0 & 3] + (d0 >> 2) * 128;
        bf16x8 b0 = *reinterpret_cast<const bf16x8*>(a);
        bf16x8 b1 = *reinterpret_cast<const bf16x8*>(a + 32 * 256);
        p0 = __builtin_amdgcn_mfma_f32_32x32x16_bf16(b0, qr[d0], p0, 0, 0, 0);
        p1 = __builtin_amdgcn_mfma_f32_32x32x16_bf16(b1, qr[d0], p1, 0, 0, 0); }
}
template <int VB>
__device__ __forceinline__ void pv_tile(f32x16* o, int vb0, bf16x8 pa0, bf16x8 pa1, bf16x8 pa2, bf16x8 pa3) {
#define TRRD(dst, off) asm volatile("ds_read_b64_tr_b16 %0, %1 offset:%2" : "=&v"(dst) : "v"(vb0), "i"(off) : "memory")
#define PV_D0(d0) do { s16x4 l0, l1, l2, l3, h0, h1, h2, h3; constexpr int b_ = VB * SHM_V + v_rd_off(d0, 0, 0); \
        TRRD(l0, b_); TRRD(h0, b_ + 2048); TRRD(l1, b_ + 4096); TRRD(h1, b_ + 6144); TRRD(l2, b_ + 8192); TRRD(h2, b_ + 10240); TRRD(l3, b_ + 12288); TRRD(h3, b_ + 14336); \
        asm volatile("s_waitcnt lgkmcnt(0)" ::: "memory"); SBAR();   \
        o[d0] = __builtin_amdgcn_mfma_f32_32x32x16_bf16(pa0, (bf16x8){l0[0], l0[1], l0[2], l0[3], h0[0], h0[1], h0[2], h0[3]}, o[d0], 0, 0, 0);   \
        o[d0] = __builtin_amdgcn_mfma_f32_32x32x16_bf16(pa1, (bf16x8){l1[0], l1[1], l1[2], l1[3], h1[0], h1[1], h1[2], h1[3]}, o[d0], 0, 0, 0);   \
        o[d0] = __builtin_amdgcn_mfma_f32_32x32x16_bf16(pa2, (bf16x8){l2[0], l2[1], l2[2], l2[3], h2[0], h2[1], h2[2], h2[3]}, o[d0], 0, 0, 0);   \
        o[d0] = __builtin_amdgcn_mfma_f32_32x32x16_bf16(pa3, (bf16x8){l3[0], l3[1], l3[2], l3[3], h3[0], h3[1], h3[2], h3[3]}, o[d0], 0, 0, 0); } while (0)
    PV_D0(0); PV_D0(1); PV_D0(2); PV_D0(3);
#undef PV_D0
#undef TRRD
}
struct Bases { bf16* Q; const bf16* K; const bf16* V; const float* NB; };
struct BlockRef { unsigned ro; int bh; int P0; };
#define RQ(R) (Bs.Q + (size_t)(R).ro + (size_t)(R).P0 * PITCH)
#define RK(R) (Bs.K + (size_t)(R).ro)
#define RV(R) (Bs.V + (size_t)(R).ro)
#define RNB(R) (Bs.NB + (size_t)(R).bh * 8192)
struct Seam { bf16x8 qr[8]; bf16x8 st_v0, st_v1, st_k0, st_k1; float st_b; };
#define ROWP(p, k0, rc) ((const bf16*)((const char*)((p) + ((size_t)(k0) + (rc)) * PITCH) + toffB))
#define VMW() asm volatile("s_waitcnt vmcnt(0)" ::: "memory")
#define VMWN(n) asm volatile("s_waitcnt vmcnt(%0)" :: "i"(n) : "memory")
#define SLOAD_H(R, k0) do { S.st_v0 = load8(ROWP(RV(R), k0, 0)); S.st_v1 = load8(ROWP(RV(R), k0, 32));              \
                         S.st_k0 = load8(ROWP(RK(R), k0, 0)); S.st_k1 = load8(ROWP(RK(R), k0, 32)); S.st_b = RNB(R)[(k0) + (tid & 63)]; } while (0)
#define SWRITE_HK(bf) do { *(bf16x8*)(K_lds + (bf) * SHM_K + kws) = S.st_k0; *(bf16x8*)(K_lds + (bf) * SHM_K + kws + 32 * 256) = S.st_k1; \
                           if (tid < 64) B_lds[(bf) * 64 + tid] = S.st_b; } while (0)
#define SWRITE_HV(bf) do { *(bf16x8*)(V_lds + (bf) * SHM_V + vst0) = S.st_v0; *(bf16x8*)(V_lds + (bf) * SHM_V + vst1) = S.st_v1; } while (0)
#define SWRITE_H(bf) do { SWRITE_HV(bf); SWRITE_HK(bf); } while (0)
__device__ __forceinline__ void prime(const Bases& Bs, const BlockRef& cur, char* lds, Seam& S, const int tid) {
    const int wid = __builtin_amdgcn_readfirstlane(tid >> 6), lane = tid & 63, r32 = lane & 31, hi = lane >> 5;
    const int sr = tid >> 4, sc = (tid & 15) * 8, kws = KSWZ(sr, sc * 2); char* K_lds = lds + 2 * SHM_V; float* B_lds = (float*)(lds + OFF_BIAS);
    const unsigned toffB = (unsigned)(sr * PITCH + sc) * 2u, qoffB = (unsigned)((wid * QBLK + r32) * PITCH + hi * 8) * 2u;
    for (int d0 = 0; d0 < 8; ++d0) S.qr[d0] = load8((const bf16*)((const char*)RQ(cur) + qoffB) + d0 * 16);
    SLOAD_H(cur, cur.P0 + QB - KVBLK); VMW(); SWRITE_HK(0);
    __syncthreads();
}
__device__ __forceinline__ void block(const Bases& Bs, const BlockRef& cur, const BlockRef& nxt, char* lds, Seam& S, const int tid) {
    const int wid = __builtin_amdgcn_readfirstlane(tid >> 6), lane = tid & 63, r32 = lane & 31, hi = lane >> 5;
    const unsigned W = 1u << 30;
    const int NT = (cur.P0 + QB) / KVBLK;
    const int qlo = cur.P0 + wid * QBLK;
    char* V_lds = lds; char* K_lds = lds + 2 * SHM_V; float* B_lds = (float*)(lds + OFF_BIAS);
    float* ws = (float*)(lds + OFF_WS) + wid * 64; float* li_l = ws, * al_l = ws + 32;
    float m_reg = -1e30f, l_reg = 0; f32x16 o[4] = {};
    const int sr = tid >> 4, sc = (tid & 15) * 8, vst0 = v_st(sr, sc), vst1 = v_st(32 + sr, sc), kws = KSWZ(sr, sc * 2);
    const unsigned toffB = (unsigned)(sr * PITCH + sc) * 2u;
    const int vb0 = (int)(uintptr_t)V_lds + v_rd_base(lane);
#define RESC(a) do { if (__any((a) < 1.f)) { if (hi == 0) al_l[r32] = (a); asm volatile("s_waitcnt lgkmcnt(0)" ::: "memory");              \
                     for (int d_ = 0; d_ < 4; ++d_) for (int r = 0; r < 16; ++r) o[d_][r] *= al_l[crow(r, hi)]; } } while (0)
#define KBASE(t) ((NT - 1 - (t)) * KVBLK)
#define MASKT(P0_, P1_, t) do { const int kb_ = KBASE(t); if (kb_ + KVBLK - 1 > qlo) { int tm_ = tid; asm volatile("" : "+v"(tm_)); mask_tile(P0_, P1_, qlo + (tm_ & 31) - 4 * ((tm_ >> 5) & 1) - kb_, W); } } while (0)
    constexpr int NQL = 8;
#define SEAM_K0() do { VMWN(NQL); SWRITE_HK(0); SBAR(); } while (0)
    f32x16 pA0, pA1, pB0, pB1; float mnA, mnB, alA, alB; bf16x8 pa0, pa1, pa2, pa3;
    SWRITE_HV(0); SBAR();
    SLOAD_H(cur, KBASE(1));
    SBAR(); qkt<0>(pA0, pA1, K_lds, B_lds, r32, hi, S.qr);
    MASKT(pA0, pA1, 0); partialSM(pA0, pA1, m_reg, mnA, alA);
    { VMW(); SWRITE_H(1); }
    __syncthreads();
#define HALF_STEP(PX0, PX1, mnX, alX, PY0, PY1, alY, t, KB, VB, SB) do {                                                      \
        SBAR(); qkt<KB>(PX0, PX1, K_lds, B_lds, r32, hi, S.qr);                                             \
        finishSM(PY0, PY1, alY, l_reg, pa0, pa1, pa2, pa3); SBAR();                                                           \
        if ((t) + 1 < NT) { SLOAD_H(cur, KBASE((t) + 1)); SBAR(); }                                               \
        pv_tile<VB>(o, vb0, pa0, pa1, pa2, pa3); MASKT(PX0, PX1, (t)); partialSM(PX0, PX1, m_reg, mnX, alX);                                        \
        __syncthreads();                                                                                                      \
        if ((t) + 1 < NT) { VMW(); SWRITE_H(SB); }                                                                          \
        RESC(alX); __syncthreads(); } while (0)
    for (int t = 1; t + 1 < NT; t += 2) {
        HALF_STEP(pB0, pB1, mnB, alB, pA0, pA1, alA, t, 1, 0, 0);
        HALF_STEP(pA0, pA1, mnA, alA, pB0, pB1, alB, t + 1, 0, 1, 1);
    }
    constexpr bool even = true;
    if (even) { SBAR(); qkt<1>(pB0, pB1, K_lds, B_lds, r32, hi, S.qr); SBAR(); }
    SLOAD_H(nxt, nxt.P0 + QB - KVBLK); SBAR();
    int tq_ = tid; asm volatile("" : "+v"(tq_));
    const unsigned qoffB = (unsigned)(((tq_ >> 6) * QBLK + (tq_ & 31)) * PITCH + ((tq_ >> 5) & 1) * 8) * 2u;
#pragma unroll
    for (int d0 = 0; d0 < 8; ++d0) S.qr[d0] = load8((const bf16*)((const char*)RQ(nxt) + qoffB) + d0 * 16);
    SBAR();
    finishSM(pA0, pA1, alA, l_reg, pa0, pa1, pa2, pa3); SBAR();
    pv_tile<0>(o, vb0, pa0, pa1, pa2, pa3);
    if (even) { MASKT(pB0, pB1, NT - 1); partialSM(pB0, pB1, m_reg, mnB, alB); __syncthreads(); RESC(alB);
        finishSM(pB0, pB1, alB, l_reg, pa0, pa1, pa2, pa3); SBAR(); pv_tile<1>(o, vb0, pa0, pa1, pa2, pa3); }
    SBAR(); SEAM_K0();
    if (hi == 0) li_l[r32] = l_reg; asm volatile("s_waitcnt lgkmcnt(0)" ::: "memory");
    float rli[16];
#pragma unroll
    for (int r = 0; r < 16; ++r) rli[r] = __builtin_amdgcn_rcpf(li_l[crow(r, hi)]);
    int to_ = tid; asm volatile("" : "+v"(to_));
    const unsigned ooffB = (unsigned)(((to_ >> 6) * QBLK + 4 * ((to_ >> 5) & 1)) * PITCH + (to_ & 31)) * 2u;
    char* Ow = (char*)RQ(cur) + ooffB;
#pragma unroll
    for (int r = 0; r < 16; ++r) { const int orow0 = (r & 3) + 8 * (r >> 2);
#pragma unroll
        for (int d0 = 0; d0 < 4; ++d0) { const float v = o[d0][r] * rli[r];
            const float vn = __shfl_xor(v, 1);
            if ((r32 & 1) == 0) *(unsigned*)(Ow + (size_t)(orow0 * PITCH + d0 * 32) * 2) = cvtpk(v, vn); } }
    __syncthreads();
#undef RESC
#undef KBASE
#undef MASKT
#undef SEAM_K0
#undef HALF_STEP
}
#undef ROWP
#undef RQ
#undef RK
#undef RV
#undef RNB
#undef VMW
#undef VMWN
#undef SLOAD_H
#undef SWRITE_HK
#undef SWRITE_HV
#undef SWRITE_H
#undef KSWZ
#undef SBAR
}

#define LAS __attribute__((address_space(3)))
typedef unsigned short bf16_t;
typedef unsigned v4u __attribute__((ext_vector_type(4)));
typedef unsigned v2u __attribute__((ext_vector_type(2)));
typedef float f32x4 __attribute__((ext_vector_type(4)));
typedef short bf16x8 __attribute__((ext_vector_type(8)));
typedef short s16x4 __attribute__((ext_vector_type(4)));
#define LDS_WAIT() asm volatile("s_waitcnt lgkmcnt(0)" ::: "memory")

constexpr int NWAVES = 8;
constexpr int M = 16384, DM = 2048, DFF = 5632, T = 8192, NCH = 128;
constexpr int IN_W = 18464;
constexpr float EPS = 1e-6f;
constexpr size_t MiB = 1u << 20;
constexpr size_t WS_CTL = 0;
constexpr size_t WS_PS = 1 * MiB;
constexpr size_t WS_ACH = 3 * MiB;
constexpr size_t WS_NB = 4 * MiB;
constexpr size_t WS_OSQ = 530 * MiB;
constexpr size_t WS_RS = 6 * MiB;
constexpr size_t WS_WB = 8 * MiB;
constexpr size_t WS_WA = 40 * MiB;
constexpr size_t WS_XN = 114 * MiB;
constexpr size_t WS_FV = 178 * MiB, WS_FK = 242 * MiB, WS_FQ = 306 * MiB, WS_GV = 370 * MiB, WS_GQ = 434 * MiB, WS_GK = 466 * MiB, WS_KT = 498 * MiB, WS_END = 538 * MiB;
constexpr size_t WS_H = WS_FV;
constexpr size_t WS_MGF = WS_FV;
constexpr size_t WS_SG = WS_GQ, WS_SF = WS_FK;
constexpr int LDS_BYTES = 153600;

__device__ __forceinline__ unsigned f2bf(float f) { unsigned u = __builtin_bit_cast(unsigned, f); return (u + 0x7fffu + ((u >> 16) & 1u)) >> 16; }
__device__ __forceinline__ unsigned pk2(float lo, float hi) { return f2bf(lo) | (f2bf(hi) << 16); }
__device__ __forceinline__ float bfu(unsigned short h) { return __uint_as_float((unsigned)h << 16); }
__device__ __forceinline__ float wave_sum(float v) {
#pragma unroll
    for (int o = 1; o < 64; o <<= 1) v += __shfl_xor(v, o);
    return v;
}
__device__ __forceinline__ float logsig(float z) { return fminf(z, 0.f) - __logf(1.0f + __expf(-fabsf(z))); }

typedef float f32x2m __attribute__((ext_vector_type(2)));
__device__ __forceinline__ void tr_item(const float* W, int N, bf16_t* WT, int ldk, int k0, int drow0, int a0, int b0, int a1, int b1, const float* gk, LAS float* scr, int lane) {
    const int n = 2 * (lane & 31), within = n & 31; const int sa = (n >> 5) ? a1 : a0, sb = (n >> 5) ? b1 : b0; const int sc = (within < 16) ? sa + within : sb + (within - 16);
#pragma unroll 8
    for (int i = 0; i < 32; ++i) { const int kk = 2 * i + (lane >> 5); const float gg = gk ? gk[k0 + kk] : 1.0f;
        const f32x2m v = __builtin_nontemporal_load((const f32x2m*)(W + (size_t)(k0 + kk) * N + sc));     scr[kk * 65 + n] = v.x * gg; scr[kk * 65 + n + 1] = v.y * gg; }
    LDS_WAIT(); asm volatile("" ::: "memory");
    const int c = lane & 7;
#pragma unroll
    for (int j = 0; j < 8; ++j) { const int n2 = (lane >> 3) + 8 * j; const LAS float* s = scr + (8 * c) * 65 + n2;
        v4u o; o.x = pk2(s[0 * 65], s[1 * 65]); o.y = pk2(s[2 * 65], s[3 * 65]); o.z = pk2(s[4 * 65], s[5 * 65]); o.w = pk2(s[6 * 65], s[7 * 65]);
        *(v4u*)(WT + (size_t)(drow0 + n2) * ldk + k0 + 8 * c) = o; }
    LDS_WAIT(); asm volatile("" ::: "memory");
}
enum { CM_ID = 0, CM_SWIGLU = 1, CM_WIN = 2 };
__device__ __forceinline__ void conv_map(int mode, int d0, int& srcA, int& srcB) {
    if (mode == CM_ID) { srcA = d0; srcB = d0 + 16; }
    else if (mode == CM_SWIGLU) { const int tile = d0 >> 8, w = d0 & 255; srcA = (w >> 7) * DFF + tile * 128 + (w & 127); srcB = srcA + 16; }
    else { int s;
        if (d0 < 4096) s = d0;
        else if (d0 < 10240) s = 6160 + (d0 - 4096);
        else if (d0 < 12288) s = 4096 + (d0 - 10240);
        else if (d0 < 18432) s = 12320 + (d0 - 12288);
        else { srcA = 6144; srcB = 12304; return; }
        srcA = s; srcB = s + 16; }
}
__device__ __forceinline__ void conv_range(const float* W, int K, int N, bf16_t* WT, int ldk, int ndest, int mode, const float* gk, int& base, int gw, int NGW, LAS float* scr, int lane) {
    const int nblk = (ndest + 63) / 64, nitems = (K / 64) * nblk;
    int it = gw - (base % NGW); if (it < 0) it += NGW;
    for (; it < nitems; it += NGW) { const int kb = it / nblk, nb = it % nblk; int a0, b0, a1, b1; conv_map(mode, nb * 64, a0, b0); conv_map(mode, nb * 64 + 32, a1, b1);
        tr_item(W, N, WT, ldk, kb * 64, nb * 64, a0, b0, a1, b1, gk, scr, lane); }
    base += nitems;
}
__device__ __forceinline__ void rms_rows_bf16(const float* x, const float* g, bf16_t* out, int gw, int NGW, int lane) {
    f32x4 gv[8];
#pragma unroll
    for (int j = 0; j < 8; ++j) gv[j] = ((const f32x4*)g)[lane + 64 * j];
    f32x4 nx[8];
    if (gw < M) { const f32x4* xr = (const f32x4*)(x + (size_t)gw * DM) + lane;
#pragma unroll
        for (int j = 0; j < 8; ++j) nx[j] = __builtin_nontemporal_load(xr + 64 * j); }
    for (int m = gw; m < M; m += NGW) {
        f32x4 v[8]; float s = 0.f;
#pragma unroll
        for (int j = 0; j < 8; ++j) v[j] = nx[j];
        if (m + NGW < M) { const f32x4* xr = (const f32x4*)(x + (size_t)(m + NGW) * DM) + lane;
#pragma unroll
            for (int j = 0; j < 8; ++j) nx[j] = __builtin_nontemporal_load(xr + 64 * j); }
#pragma unroll
        for (int j = 0; j < 8; ++j) s += (v[j].x * v[j].x + v[j].y * v[j].y) + (v[j].z * v[j].z + v[j].w * v[j].w);
        const float rstd = __builtin_amdgcn_rsqf(wave_sum(s) * (1.f / DM) + EPS);
        v2u* o8 = (v2u*)(out + (size_t)m * DM) + lane;
#pragma unroll
        for (int j = 0; j < 8; ++j) { v2u w; w.x = pk2(v[j].x * rstd * gv[j].x, v[j].y * rstd * gv[j].y); w.y = pk2(v[j].z * rstd * gv[j].z, v[j].w * rstd * gv[j].w); o8[64 * j] = w; }
    }
}
__device__ __forceinline__ void rms_rows_f32(float* x, const float* g, int gw, int NGW, int lane) {
    f32x4 gv[8];
#pragma unroll
    for (int j = 0; j < 8; ++j) gv[j] = ((const f32x4*)g)[lane + 64 * j];
    f32x4 nx[8];
    if (gw < M) { const f32x4* xr = (const f32x4*)(x + (size_t)gw * DM) + lane;
#pragma unroll
        for (int j = 0; j < 8; ++j) nx[j] = xr[64 * j]; }
    for (int m = gw; m < M; m += NGW) {
        f32x4* xw = (f32x4*)(x + (size_t)m * DM) + lane; f32x4 v[8]; float s = 0.f;
#pragma unroll
        for (int j = 0; j < 8; ++j) v[j] = nx[j];
        if (m + NGW < M) { const f32x4* xr = (const f32x4*)(x + (size_t)(m + NGW) * DM) + lane;
#pragma unroll
            for (int j = 0; j < 8; ++j) nx[j] = xr[64 * j]; }
#pragma unroll
        for (int j = 0; j < 8; ++j) s += (v[j].x * v[j].x + v[j].y * v[j].y) + (v[j].z * v[j].z + v[j].w * v[j].w);
        const float rstd = __builtin_amdgcn_rsqf(wave_sum(s) * (1.f / DM) + EPS);
#pragma unroll
        for (int j = 0; j < 8; ++j) __builtin_nontemporal_store(v[j] * rstd * gv[j], xw + 64 * j);
    }
}
__device__ __forceinline__ void small_proj(const bf16_t* XN, const bf16_t* Wsm, float* PS, const float* rs, LAS unsigned char* lds, int wg, int G, int wid, int lane) {
    const int n16 = lane & 15, kq = lane >> 4; LAS f32x4* red = (LAS f32x4*)lds;
    for (int item = wg; item < M / 64; item += G) {
        const int rg = wid & 3, kh = wid >> 2, row = item * 64 + rg * 16 + n16;
        const bf16_t* ap = XN + (size_t)row * DM + kh * 1024 + kq * 8;
        const bf16_t* bp0 = Wsm + (size_t)n16 * DM + kh * 1024 + kq * 8; const bf16_t* bp1 = bp0 + (size_t)16 * DM;
        f32x4 a0 = {0.f, 0.f, 0.f, 0.f}, a1 = {0.f, 0.f, 0.f, 0.f};
#pragma unroll 8
        for (int ks = 0; ks < 32; ++ks) { const bf16x8 a = *(const bf16x8*)(ap + ks * 32), b0 = *(const bf16x8*)(bp0 + ks * 32), b1 = *(const bf16x8*)(bp1 + ks * 32);
            a0 = __builtin_amdgcn_mfma_f32_16x16x32_bf16(a, b0, a0, 0, 0, 0); a1 = __builtin_amdgcn_mfma_f32_16x16x32_bf16(a, b1, a1, 0, 0, 0); }
        if (kh == 1) { red[(rg * 2 + 0) * 64 + lane] = a0; red[(rg * 2 + 1) * 64 + lane] = a1; }
        __syncthreads();
        if (kh == 0) { a0 += red[(rg * 2 + 0) * 64 + lane]; a1 += red[(rg * 2 + 1) * 64 + lane];
#pragma unroll
            for (int r = 0; r < 4; ++r) { const int row = item * 64 + rg * 16 + 4 * kq + r; const float rstd = __builtin_amdgcn_rsqf(rs[row] * (1.0f / 2048.0f) + 1e-6f); float* pr = PS + (size_t)row * 32; pr[n16] = a0[r] * rstd; pr[16 + n16] = a1[r] * rstd; } }
        __syncthreads();
    }
}
__device__ __forceinline__ void fox_qk_norm(bf16_t* FQ, bf16_t* FK, const float* gq, const float* gk, int gw, int NGW, int lane) {
    const int d = (lane & 15) * 8; float gqv[8], gkv[8];
#pragma unroll
    for (int i = 0; i < 8; ++i) { gqv[i] = gq[d + i] * (0.08838834764831845f * 1.4426950408889634f); gkv[i] = gk[d + i]; }
    v4u nx[2][4];
    if (gw < M) {
#pragma unroll
        for (int j = 0; j < 4; ++j) { nx[0][j] = *((const v4u*)(FQ + (size_t)gw * DM + j * 512) + lane); nx[1][j] = *((const v4u*)(FK + (size_t)gw * DM + j * 512) + lane); } }
    for (int m = gw; m < M; m += NGW) {
        v4u cur[2][4];
#pragma unroll
        for (int w = 0; w < 2; ++w)
#pragma unroll
            for (int j = 0; j < 4; ++j) cur[w][j] = nx[w][j];
        if (m + NGW < M) {
#pragma unroll
            for (int j = 0; j < 4; ++j) { nx[0][j] = *((const v4u*)(FQ + (size_t)(m + NGW) * DM + j * 512) + lane); nx[1][j] = *((const v4u*)(FK + (size_t)(m + NGW) * DM + j * 512) + lane); } }
#pragma unroll
        for (int which = 0; which < 2; ++which) { bf16_t* rowp = (which ? FK : FQ) + (size_t)m * DM;
#pragma unroll
            for (int j = 0; j < 4; ++j) { v4u* p = (v4u*)(rowp + j * 512) + lane; const v4u w = cur[which][j]; float v[8] = {__uint_as_float(w.x << 16), __uint_as_float(w.x & 0xffff0000u), __uint_as_float(w.y << 16), __uint_as_float(w.y & 0xffff0000u),
                    __uint_as_float(w.z << 16), __uint_as_float(w.z & 0xffff0000u), __uint_as_float(w.w << 16), __uint_as_float(w.w & 0xffff0000u)};
                float s = 0.f;
#pragma unroll
                for (int i = 0; i < 8; ++i) s += v[i] * v[i];
                s += __shfl_xor(s, 1); s += __shfl_xor(s, 2); s += __shfl_xor(s, 4); s += __shfl_xor(s, 8);
                const float rstd = __builtin_amdgcn_rsqf(s * (1.f / 128.f) + EPS);
                v4u o;
                if (which == 0) { o.x = pk2(v[0] * rstd * gqv[0], v[1] * rstd * gqv[1]); o.y = pk2(v[2] * rstd * gqv[2], v[3] * rstd * gqv[3]); o.z = pk2(v[4] * rstd * gqv[4], v[5] * rstd * gqv[5]); o.w = pk2(v[6] * rstd * gqv[6], v[7] * rstd * gqv[7]); }
                else { o.x = pk2(v[0] * rstd * gkv[0], v[1] * rstd * gkv[1]); o.y = pk2(v[2] * rstd * gkv[2], v[3] * rstd * gkv[3]); o.z = pk2(v[4] * rstd * gkv[4], v[5] * rstd * gkv[5]); o.w = pk2(v[6] * rstd * gkv[6], v[7] * rstd * gkv[7]); }
                *p = o; } }
    }
}
__device__ __forceinline__ void fox_cumsum(const float* PS, const float* b_f, float* NB, int bh, LAS unsigned char* lds, int wid, int lane) {
    const int b = bh >> 4, h = bh & 15; const float bf = b_f[h]; LAS float* tot = (LAS float*)lds;
    const int t0 = wid * 1024 + lane * 16;
    const float* src = PS + ((size_t)b * T + t0) * 32 + 16 + h;
    float ls[16]; float s = 0.f;
#pragma unroll
    for (int i = 0; i < 16; ++i) { ls[i] = logsig(src[(size_t)i * 32] + bf); s += ls[i]; }
    float incl = s;
#pragma unroll
    for (int o = 1; o < 64; o <<= 1) { const float t = __shfl_up(incl, o); if (lane >= o) incl += t; }
    if (lane == 63) tot[wid] = incl;
    __syncthreads();
    float run = incl - s;
#pragma unroll
    for (int w = 0; w < 8; ++w) if (w < wid) run += tot[w];
    float* dst = NB + (size_t)bh * T + t0;
#pragma unroll
    for (int q = 0; q < 4; ++q) { f32x4 o;
#pragma unroll
        for (int i = 0; i < 4; ++i) { run += ls[4 * q + i]; o[i] = -run * 1.4426950408889634f; }
        *(f32x4*)(dst + 4 * q) = o; }
    __syncthreads();
}
__device__ __forceinline__ void gla_prep_item(int item, const float* PS, const float* w_up, const float* b_a, const bf16_t* GK, bf16_t* KT, float* ACH, LAS unsigned char* lds, int tid) {
    const int h = item & 3, c = (item >> 2) & 127, b = item >> 9; const int col = tid & 255, half = tid >> 8;
    LAS float* alr_s = (LAS float*)lds; LAS float* tot_s = alr_s + 64 * 16;
    const size_t row0 = (size_t)b * T + (size_t)c * 64;
#pragma unroll
    for (int i = 0; i < 2; ++i) { const int e = tid + 512 * i; alr_s[e] = PS[(row0 + (e >> 4)) * 32 + (e & 15)]; }
    float w[16];
#pragma unroll
    for (int j = 0; j < 16; ++j) w[j] = w_up[j * 1024 + h * 256 + col];
    const float ba = b_a[h * 256 + col];
    __syncthreads();
    float Gv[32]; float run = 0.f;
#pragma unroll
    for (int r = 0; r < 32; ++r) { const LAS f32x4* ar = (const LAS f32x4*)(alr_s + (half * 32 + r) * 16); float z = ba;
#pragma unroll
        for (int q = 0; q < 4; ++q) { const f32x4 a = ar[q]; z += a.x * w[4 * q] + a.y * w[4 * q + 1] + a.z * w[4 * q + 2] + a.w * w[4 * q + 3]; }
        run += logsig(z) * (1.0f / 16.0f); Gv[r] = run; }
    tot_s[half * 256 + col] = run;
    __syncthreads();
    const float t0 = tot_s[col], t1 = tot_s[256 + col], Gend = t0 + t1, off = half ? t0 : 0.f;
    const bf16_t* kp = GK + (row0 + half * 32) * 1024 + h * 256 + col;
    unsigned pk[16];
#pragma unroll
    for (int r = 0; r < 32; r += 2) { const float k0 = bfu(kp[(size_t)r * 1024]) * __expf(Gend - (Gv[r] + off)), k1 = bfu(kp[(size_t)(r + 1) * 1024]) * __expf(Gend - (Gv[r + 1] + off)); pk[r >> 1] = pk2(k0, k1); }
    v4u* dst = (v4u*)(KT + ((((size_t)b * NCH + c) * 4 + h) * 256 + col) * 64 + half * 32);
#pragma unroll
    for (int q = 0; q < 4; ++q) dst[q] = (v4u){pk[4 * q], pk[4 * q + 1], pk[4 * q + 2], pk[4 * q + 3]};
    if (half == 0) ACH[((size_t)b * NCH + c) * 1024 + h * 256 + col] = __expf(Gend);
    __syncthreads();
}
constexpr int GL_K = 0, GL_Q = 32768, GL_A = 65536, GL_BUF = 66560, GL_X = 2 * GL_BUF, GL_END = GL_X + 16384;
__device__ __forceinline__ void gla_scan(int unit, const bf16_t* KT, const bf16_t* GQ, bf16_t* GV, const float* ACH, float* OSQ, LAS unsigned char* lds, int tid, int wid, int lane) {
    const int slab = unit & 7, h = (unit >> 3) & 3, b = unit >> 5; const int n16 = lane & 15, q4 = lane >> 4, dvg = wid & 3, dkh = wid >> 2;
    f32x4 S[8];
#pragma unroll
    for (int i = 0; i < 8; ++i) S[i] = (f32x4){0.f, 0.f, 0.f, 0.f};
    v4u rk[4], rq[4], ra; unsigned short rv[16];
    const size_t vcol = (size_t)h * 512 + slab * 64 + dvg * 16 + n16;
#define GL_LOAD(c) do { const bf16_t* kt = KT + (((size_t)b * NCH + (c)) * 4 + h) * 256 * 64; const bf16_t* qc = GQ + ((size_t)b * T + (size_t)(c) * 64) * 1024 + h * 256; \
        _Pragma("unroll") for (int i = 0; i < 4; ++i) { const int p = tid + 512 * i; rk[i] = *(const v4u*)(kt + (size_t)p * 8); rq[i] = *(const v4u*)(qc + (size_t)(p >> 5) * 1024 + (p & 31) * 8); } \
        if (tid < 64) ra = *(const v4u*)(ACH + ((size_t)b * NCH + (c)) * 1024 + h * 256 + tid * 4); \
        const bf16_t* vc = GV + ((size_t)b * T + (size_t)(c) * 64) * 2048 + vcol; \
        _Pragma("unroll") for (int i = 0; i < 16; ++i) rv[i] = vc[(size_t)((i >> 3) * 32 + 8 * q4 + (i & 7)) * 2048]; } while (0)
#define GL_STORE(buf) do { LAS unsigned char* bb = lds + (buf) * GL_BUF; \
        _Pragma("unroll") for (int i = 0; i < 4; ++i) { const int p = tid + 512 * i; *(LAS v4u*)(bb + GL_K + (p >> 3) * 128 + (((p & 7) ^ ((p >> 3) & 7)) * 16)) = rk[i]; *(LAS v4u*)(bb + GL_Q + (p >> 5) * 512 + (((p & 31) ^ ((p >> 5) & 15)) * 16)) = rq[i]; } \
        if (tid < 64) *(LAS v4u*)(bb + GL_A + tid * 16) = ra; } while (0)
    GL_LOAD(0); GL_STORE(0);
    __syncthreads();
    for (int c = 0; c < NCH; ++c) {
        const int buf = c & 1; LAS unsigned char* bb = lds + buf * GL_BUF;
        bf16x8 vf[2];
#pragma unroll
        for (int ks = 0; ks < 2; ++ks) { v4u w; w.x = rv[8 * ks] | ((unsigned)rv[8 * ks + 1] << 16); w.y = rv[8 * ks + 2] | ((unsigned)rv[8 * ks + 3] << 16); w.z = rv[8 * ks + 4] | ((unsigned)rv[8 * ks + 5] << 16); w.w = rv[8 * ks + 6] | ((unsigned)rv[8 * ks + 7] << 16); vf[ks] = __builtin_bit_cast(bf16x8, w); }
        if (c + 1 < NCH) GL_LOAD(c + 1);
#pragma unroll
        for (int i = 0; i < 8; ++i) { const int row = dkh * 128 + 16 * i + n16; const f32x4 av = *(const LAS f32x4*)(bb + GL_A + (dkh * 128 + 16 * i + 4 * q4) * 4); S[i] = S[i] * av;
#pragma unroll
            for (int ks = 0; ks < 2; ++ks) { const bf16x8 a = *(const LAS bf16x8*)(bb + GL_K + row * 128 + (((4 * ks + q4) ^ (n16 & 7)) * 16));
                S[i] = __builtin_amdgcn_mfma_f32_16x16x32_bf16(a, vf[ks], S[i], 0, 0, 0); } }
        f32x4 o[4];
#pragma unroll
        for (int ct = 0; ct < 4; ++ct) o[ct] = (f32x4){0.f, 0.f, 0.f, 0.f};
#pragma unroll
        for (int j = 0; j < 4; ++j) { v4u bw; bw.x = pg8::cvt_pk_bf16(S[2 * j][0], S[2 * j][1]); bw.y = pg8::cvt_pk_bf16(S[2 * j][2], S[2 * j][3]); bw.z = pg8::cvt_pk_bf16(S[2 * j + 1][0], S[2 * j + 1][1]); bw.w = pg8::cvt_pk_bf16(S[2 * j + 1][2], S[2 * j + 1][3]);
            const bf16x8 bfr = __builtin_bit_cast(bf16x8, bw);
#pragma unroll
            for (int ct = 0; ct < 4; ++ct) { const LAS unsigned char* qrow = bb + GL_Q + (16 * ct + n16) * 512;
                const int e0 = dkh * 32 + 8 * j + q4; const v2u lo = *(const LAS v2u*)(qrow + ((e0 ^ (n16 << 1)) * 8)), hi = *(const LAS v2u*)(qrow + (((e0 + 4) ^ (n16 << 1)) * 8)); const v4u aw = {lo.x, lo.y, hi.x, hi.y};
                o[ct] = __builtin_amdgcn_mfma_f32_16x16x32_bf16(__builtin_bit_cast(bf16x8, aw), bfr, o[ct], 0, 0, 0); } }
        LAS f32x4* xch = (LAS f32x4*)(lds + GL_X);
        if (dkh == 0) { xch[((dvg * 2 + 0) * 2 + 0) * 64 + lane] = o[2]; xch[((dvg * 2 + 0) * 2 + 1) * 64 + lane] = o[3]; }
        else          { xch[((dvg * 2 + 1) * 2 + 0) * 64 + lane] = o[0]; xch[((dvg * 2 + 1) * 2 + 1) * 64 + lane] = o[1]; }
        __syncthreads();
#pragma unroll
        for (int t = 0; t < 2; ++t) { const int ct = 2 * dkh + t; const f32x4 mine = dkh == 0 ? o[t] : o[2 + t]; const f32x4 s = mine + xch[((dvg * 2 + (1 - dkh)) * 2 + t) * 64 + lane];
            bf16_t* oc = GV + ((size_t)b * T + (size_t)c * 64 + 16 * ct + 4 * q4) * 2048 + vcol;
            float* osqp = OSQ + ((size_t)b * T + (size_t)c * 64 + 16 * ct + 4 * q4) * 128 + h * 32 + slab * 4 + dvg;
#pragma unroll
            for (int r = 0; r < 4; ++r) { const float v = s[r] * 0.0625f; float sq = v * v;
                sq += __shfl_xor(sq, 1); sq += __shfl_xor(sq, 2); sq += __shfl_xor(sq, 4); sq += __shfl_xor(sq, 8);
                if (n16 == 0) osqp[(size_t)r * 128] = sq;
                oc[(size_t)r * 2048] = (bf16_t)f2bf(v); } }
        if (c + 1 < NCH) GL_STORE(buf ^ 1);
        __syncthreads();
    }
#undef GL_LOAD
#undef GL_STORE
}

#define XB_TMO      128
#define XB_XCNT(j)  (256  + 64 * (j))
#define XB_XSUB(j)  (1280 + 64 * (j))
#define XB_XGEN(j)  (2304 + 64 * (j))
#define XB_TOP      3328
#define XB_TOPGEN   3392
#define XCD_BAR_WORDS 3456
#define XB_SPIN_CAP (1u << 18)

__device__ __forceinline__ unsigned xb_ld(unsigned* p)              { return __hip_atomic_load(p, __ATOMIC_RELAXED, __HIP_MEMORY_SCOPE_AGENT); }
__device__ __forceinline__ unsigned xb_add(unsigned* p, unsigned v) { return __hip_atomic_fetch_add(p, v, __ATOMIC_RELAXED, __HIP_MEMORY_SCOPE_AGENT); }
__device__ __forceinline__ unsigned xb_xcc_id() { return (unsigned)__builtin_amdgcn_s_getreg((3 << 11) | 20) & 0xFu; }
#define XB_SPIN(cond, bar) do { unsigned _sp = 0; while (cond) { __builtin_amdgcn_s_sleep(1); \
    if ((++_sp & 255u) == 0u) { if (xb_ld(&(bar)[XB_TMO])) break; if (_sp > XB_SPIN_CAP) { atomicAdd(&(bar)[XB_TMO], 1u); break; } } } } while (0)

struct XcdBarrier {
    unsigned* bar; unsigned x;
    volatile LAS unsigned* st;
};

__device__ __forceinline__ XcdBarrier xcd_barrier_post(unsigned* bar, volatile LAS unsigned* st) {
    XcdBarrier b; b.bar = bar; b.x = xb_xcc_id(); b.st = st;
    if (threadIdx.x == 0) (void)xb_add(&bar[XB_XCNT(b.x)], 1u);
    return b;
}
__device__ __forceinline__ void xcd_barrier_complete(unsigned* bar, unsigned x, unsigned& nloc, unsigned& nx) {
    const unsigned G = gridDim.x * gridDim.y * gridDim.z;
    unsigned sum, cnt, mine, sp = 0u;
    for (;;) {
        sum = 0u; cnt = 0u; mine = 0u;
#pragma unroll
        for (unsigned j = 0; j < 16; ++j) { const unsigned c = xb_ld(&bar[XB_XCNT(j)]); sum += c; cnt += (c > 0u) ? 1u : 0u; mine = (j == x) ? c : mine; }
        if (sum == G) break;
        __builtin_amdgcn_s_sleep(1);
        if ((++sp & 255u) == 0u) { if (xb_ld(&bar[XB_TMO])) break; if (sp > XB_SPIN_CAP) { atomicAdd(&bar[XB_TMO], 1u); break; } }
    }
    nloc = mine > 0u ? mine : 1u; nx = cnt > 0u ? cnt : 1u;
}

__device__ __forceinline__ void xcd_barrier(const XcdBarrier& b) {
    asm volatile("s_waitcnt vmcnt(0)" ::: "memory");
    __syncthreads();
    if (threadIdx.x == 0) {
        unsigned* bar = b.bar;
        __builtin_amdgcn_s_waitcnt(0);
        unsigned nloc = b.st[0], nx = b.st[1];
        if (nloc == 0u) { xcd_barrier_complete(bar, b.x, nloc, nx); b.st[0] = nloc; b.st[1] = nx; }
        const unsigned old = xb_add(&bar[XB_XSUB(b.x)], 1u);
        const unsigned gen = old / nloc;
        if (old + 1u == (gen + 1u) * nloc) {
            __builtin_amdgcn_fence(__ATOMIC_RELEASE, "agent");
            asm volatile("s_waitcnt vmcnt(0)" ::: "memory");
            const unsigned og = xb_add(&bar[XB_TOP], 1u);
            const unsigned tg = og / nx;
            if (og + 1u == (tg + 1u) * nx) xb_add(&bar[XB_TOPGEN], 1u);
            else XB_SPIN(xb_ld(&bar[XB_TOPGEN]) == tg, bar);
            __builtin_amdgcn_fence(__ATOMIC_ACQUIRE, "agent");
            xb_add(&bar[XB_XGEN(b.x)], 1u);
            asm volatile("s_waitcnt vmcnt(0)" ::: "memory");
        } else {
            XB_SPIN(xb_ld(&bar[XB_XGEN(b.x)]) == gen, bar);
            __builtin_amdgcn_fence(__ATOMIC_ACQUIRE, "agent");
            asm volatile("s_waitcnt vmcnt(0)" ::: "memory");
        }
    }
    __syncthreads();
}

constexpr int CW_BAR = 4096;
constexpr int LDS_MISC = LDS_BYTES - 64;
#ifndef PHMASK
#define PHMASK 0x3fff
#endif
struct Args { const float* in[20]; float* out; unsigned char* ws; int ph_lo, ph_hi; };
constexpr int N_PHASES = 14;
constexpr int N_GLA_UNITS = 64, N_ATT_ITEMS = 1024;

#define GP(T, p) ((T*)(__attribute__((address_space(1))) T*)(p))
#define PH_BEGIN \
        int tidp_ = threadIdx.x; asm volatile("" : "+v"(tidp_)); \
        const int tid = tidp_, lane = tid & 63, wid = __builtin_amdgcn_readfirstlane(tid >> 6); \
        const int G = gridDim.x, wg = blockIdx.x, gw = wg * NWAVES + wid, NGW = G * NWAVES; \
        __attribute__((address_space(1))) unsigned char* ws_ = (__attribute__((address_space(1))) unsigned char*)args.ws; asm volatile("" : "+s"(ws_)); unsigned char* ws = (unsigned char*)ws_; \
        float* out = GP(float, args.out); \
        bf16_t* XN = (bf16_t*)(ws + WS_XN); bf16_t* WA = (bf16_t*)(ws + WS_WA); bf16_t* H = (bf16_t*)(ws + WS_H); \
        bf16_t* Wbrg = (bf16_t*)(ws + WS_WB); bf16_t* Wbrf = Wbrg + (size_t)2048 * 2048; bf16_t* Wout2 = Wbrf + (size_t)2048 * 2048; \
        bf16_t *GQ = (bf16_t*)(ws + WS_GQ), *GK = (bf16_t*)(ws + WS_GK), *GV = (bf16_t*)(ws + WS_GV), *FQ = (bf16_t*)(ws + WS_FQ), *FK = (bf16_t*)(ws + WS_FK), *FV = (bf16_t*)(ws + WS_FV); \
        bf16_t *KT = (bf16_t*)(ws + WS_KT), *SG = (bf16_t*)(ws + WS_SG), *SF = (bf16_t*)(ws + WS_SF), *MGF = (bf16_t*)(ws + WS_MGF); \
        float *PS = (float*)(ws + WS_PS), *ACH = (float*)(ws + WS_ACH), *NB = (float*)(ws + WS_NB), *OSQ = (float*)(ws + WS_OSQ); \
        unsigned* ctl = (unsigned*)(ws + WS_CTL); float* RS1 = (float*)(ws + WS_RS); float* RS2 = RS1 + M; (void)RS1; (void)RS2; \
        LAS float* scr = (LAS float*)(lds + wid * 16640); \
        (void)lane; (void)gw; (void)NGW; (void)out; (void)XN; (void)WA; (void)H; (void)Wbrg; (void)Wbrf; (void)Wout2; (void)GQ; (void)GK; (void)GV; (void)FQ; (void)FK; (void)FV; (void)KT; (void)SG; (void)SF; (void)MGF; (void)PS; (void)ACH; (void)NB; (void)OSQ; (void)ctl; (void)scr;
#define IN(k) ((((PHMASK) >> (k)) & 1) && lo <= (k) && (k) < hi)
#define SEAM(k) do { if (lo <= (k) && (k) + 1 < hi) { xcd_barrier(xbar); } } while (0)
#define GEMM_UP(rs_) do { pg8::Gemm g{XN, WA, M, 2 * DFF, DM}; pg8::StaticOrder S; S.init(M, 2 * DFF, G, wg); pg8::EpiSwiGLU E{H, DFF, rs_}; \
        pg8::gemm_phase<pg8::EpiSwiGLU, pg8::StaticOrder, true, true>(lds, g, S, E, tid); } while (0)
#define GEMM_RES(BASE_BF, OUT_BF, A_, B_, K_, base_, out_, scale_, rs_) do { pg8::Gemm g{A_, B_, M, DM, K_}; pg8::StaticOrder S; S.init(M, DM, G, wg, 4); pg8::EpiResid<BASE_BF, OUT_BF> E{(const void*)(base_), (void*)(out_), scale_, rs_}; \
        pg8::gemm_phase<pg8::EpiResid<BASE_BF, OUT_BF>, pg8::StaticOrder, true, true>(lds, g, S, E, tid); } while (0)

__global__ void __launch_bounds__(NWAVES * 64, 2) fwd_mega(Args args) {
    extern __shared__ __attribute__((aligned(16))) unsigned char lds_raw[];
    LAS unsigned char* lds = (LAS unsigned char*)lds_raw;
    cg::grid_group grid = cg::this_grid();
    const int lo = args.ph_lo, hi = args.ph_hi;
    if (hi < 0) { __syncthreads(); grid.sync(); }
    { volatile LAS unsigned* misc = (volatile LAS unsigned*)(lds + LDS_MISC); if (threadIdx.x < 2) misc[threadIdx.x] = 0u; }
    __syncthreads();
    const XcdBarrier xbar = xcd_barrier_post((unsigned*)(GP(unsigned char, args.ws) + WS_CTL) + CW_BAR, (volatile LAS unsigned*)(lds + LDS_MISC));
    if (IN(0)) { PH_BEGIN
        int base = 0;
        if (wg == 0 && tid == 0) ctl[0] = 0u;
        for (int i = wg * 512 + tid; i < 2 * M; i += G * 512) RS1[i] = 0.f;
        conv_range(GP(const float, args.in[2]), DM, 2 * DFF, WA, DM, 2 * DFF, CM_SWIGLU, (const float*)nullptr, base, gw, NGW, scr, lane);
        conv_range(GP(const float, args.in[3]), DFF, DM, WA + (size_t)2 * DFF * DM, DFF, DM, CM_ID, (const float*)nullptr, base, gw, NGW, scr, lane);
        conv_range(GP(const float, args.in[12]), DM, DM, Wbrg, DM, DM, CM_ID, (const float*)nullptr, base, gw, NGW, scr, lane);
        conv_range(GP(const float, args.in[13]), DM, DM, Wbrf, DM, DM, CM_ID, (const float*)nullptr, base, gw, NGW, scr, lane);
        conv_range(GP(const float, args.in[15]), DM, DM, Wout2, DM, DM, CM_ID, (const float*)nullptr, base, gw, NGW, scr, lane);
        rms_rows_bf16(GP(const float, args.in[0]), GP(const float, args.in[1]), XN, gw, NGW, lane);
    }
    SEAM(0);
    if (IN(1)) { PH_BEGIN GEMM_UP((const float*)nullptr); }
    SEAM(1);
    if (IN(2)) { PH_BEGIN GEMM_RES(false, true, H, WA + (size_t)2 * DFF * DM, DFF, GP(const float, args.in[0]), XN, 0.5f, RS1); }
    SEAM(2);
    if (IN(3)) { PH_BEGIN
        int base = 0;
        conv_range(GP(const float, args.in[5]), DM, IN_W, WA, DM, IN_W, CM_WIN, GP(const float, args.in[4]), base, gw, NGW, scr, lane);
    }
    SEAM(3);
    if (IN(4)) {
        { PH_BEGIN small_proj(XN, WA + (size_t)18432 * DM, PS, RS1, lds, wg, G, wid, lane); }
        { PH_BEGIN
          pg8::Gemm g{XN, WA, M, 10240, DM}; pg8::StaticOrder S; S.init(M, 10240, G, wg);
          pg8::EpiQKV E{GQ, GK, GV, FQ, FK, FV, RS1};
          pg8::gemm_phase<pg8::EpiQKV, pg8::StaticOrder, true, true>(lds, g, S, E, tid); }
    }
    SEAM(4);
    if (IN(5)) { PH_BEGIN
        for (int item = wg; item < 2 * NCH * 4; item += G) gla_prep_item(item, PS, GP(const float, args.in[6]), GP(const float, args.in[7]), GK, KT, ACH, lds, tid);
        if (wg >= G - 32) fox_cumsum(PS, GP(const float, args.in[9]), NB, wg - (G - 32), lds, wid, lane);
        fox_qk_norm(FQ, FK, GP(const float, args.in[10]), GP(const float, args.in[11]), gw, NGW, lane);
    }
    SEAM(5);
    if (IN(6)) {
        if (blockIdx.x < N_GLA_UNITS) { PH_BEGIN gla_scan(wg, KT, GQ, GV, ACH, OSQ, lds, tid, wid, lane); __syncthreads(); }
        { PH_BEGIN
            LAS volatile int* nxt_s = (LAS volatile int*)(lds + fox::LDS_BYTES);
#define FOX_REF(i) ({ const int qb_ = 31 - ((i) >> 5), bh_ = (i) & 31; fox::BlockRef r_; r_.ro = (unsigned)(bh_ >> 4) * (unsigned)(T * DM) + (unsigned)(bh_ & 15) * 128u; r_.bh = bh_; r_.P0 = qb_ * 256; r_; })
            if (tid == 0) nxt_s[0] = (int)atomicAdd(ctl, 1u);
            __syncthreads();
            int cur_i = __builtin_amdgcn_readfirstlane(nxt_s[0]);
            if (cur_i < N_ATT_ITEMS) {
                const fox::Bases Bs{(fox::bf16*)FQ, (const fox::bf16*)FK, (const fox::bf16*)FV, NB};
                fox::BlockRef cur = FOX_REF(cur_i);
                fox::Seam Sm;
                fox::prime(Bs, cur, (char*)lds_raw, Sm, tid);
                for (;;) {
                    if (tid == 0) nxt_s[1] = (int)atomicAdd(ctl, 1u);
                    __syncthreads();
                    const int nxt_i = __builtin_amdgcn_readfirstlane(nxt_s[1]);
                    const fox::BlockRef nxt = nxt_i < N_ATT_ITEMS ? FOX_REF(nxt_i) : cur;
                    fox::block(Bs, cur, nxt, (char*)lds_raw, Sm, tid);
                    if (nxt_i >= N_ATT_ITEMS) break;
                    cur = nxt;
                }
            }
#undef FOX_REF
        }
    }
    SEAM(6);
    if (IN(7)) { PH_BEGIN
        pg8::Gemm g{XN, WA + (size_t)10240 * DM, M, 8192, DM}; pg8::StaticOrder S; S.init(M, 8192, G, wg);
        pg8::EpiGates E{GV, FQ, SG, SF, OSQ, GP(const float, args.in[8]), GP(const float, args.in[14]), RS1};
        pg8::gemm_phase<pg8::EpiGates, pg8::StaticOrder, true, true>(lds, g, S, E, tid);
    }
    SEAM(7);
    if (IN(8)) {
        { PH_BEGIN int base = 0;
          conv_range(GP(const float, args.in[17]), DM, 2 * DFF, WA, DM, 2 * DFF, CM_SWIGLU, GP(const float, args.in[16]), base, gw, NGW, scr, lane);
          conv_range(GP(const float, args.in[18]), DFF, DM, WA + (size_t)2 * DFF * DM, DFF, DM, CM_ID, (const float*)nullptr, base, gw, NGW, scr, lane);
          __syncthreads(); }
        { PH_BEGIN
          pg8::Gemm g{FQ, Wbrg, 2 * M, 2 * DM, DM};
          pg8::PairOrder S; S.init(M, DM, G, wg, 4);
          pg8::EpiGated E{SG, SF, MGF};
          pg8::gemm_phase<pg8::EpiGated, pg8::PairOrder, true, true>(lds, g, S, E, tid); }
    }
    SEAM(8);
    if (IN(9)) { PH_BEGIN GEMM_RES(true, true, MGF, Wout2, DM, XN, XN, 1.0f, RS2); }
    SEAM(9);
    if (IN(11)) { PH_BEGIN GEMM_UP((const float*)RS2); }
    SEAM(11);
    if (IN(12)) { PH_BEGIN GEMM_RES(true, false, H, WA + (size_t)2 * DFF * DM, DFF, XN, out, 0.5f, (float*)nullptr); }
    SEAM(12);
    if (IN(13)) { PH_BEGIN rms_rows_f32(out, GP(const float, args.in[19]), gw, NGW, lane); }
}

extern "C" void kernel_launch(void* const* d_in, const int* in_sizes, int n_in, void* d_out, int out_size, void* d_ws, size_t ws_size, hipStream_t stream) {
    static int grid = 0;
    if (grid == 0) {
        if (n_in != 20 || out_size != M * DM || ws_size < WS_END) { fprintf(stderr, "kernel_launch: unexpected shapes (n_in %d out %d ws %zu)\n", n_in, out_size, ws_size); grid = -1; return; }
        int dev = 0, cus = 0;
        (void)hipGetDevice(&dev); (void)hipDeviceGetAttribute(&cus, hipDeviceAttributeMultiprocessorCount, dev);
        (void)hipFuncSetAttribute((const void*)fwd_mega, hipFuncAttributeMaxDynamicSharedMemorySize, LDS_BYTES);
        int per_cu = 0;
        (void)hipOccupancyMaxActiveBlocksPerMultiprocessor(&per_cu, (const void*)fwd_mega, NWAVES * 64, LDS_BYTES);
        if (per_cu < 1) fprintf(stderr, "kernel_launch: occupancy query says %d blocks per CU\n", per_cu);
        (void)hipGetLastError();
        grid = cus > 0 ? cus : 256;
    }
    if (grid < 0) return;
    if (hipMemsetAsync((char*)d_ws + WS_CTL, 0, 65536, stream) != hipSuccess) { fprintf(stderr, "kernel_launch: memset of the control words failed\n"); return; }
    Args a{};
    for (int i = 0; i < 20; ++i) a.in[i] = (const float*)d_in[i];
    a.out = (float*)d_out; a.ws = (unsigned char*)d_ws;
#if MK_MULTI
    for (int ph = 0; ph < N_PHASES; ++ph) { a.ph_lo = ph; a.ph_hi = ph + 1; hipLaunchKernelGGL(fwd_mega, dim3(grid), dim3(NWAVES * 64), LDS_BYTES, stream, a); }
#else
    a.ph_lo = 0; a.ph_hi = N_PHASES;
    void* kargs[] = {&a};
    hipError_t e = hipLaunchCooperativeKernel((const void*)fwd_mega, dim3(grid), dim3(NWAVES * 64), kargs, LDS_BYTES, stream);
    if (e != hipSuccess) fprintf(stderr, "cooperative launch failed: %s (grid %d)\n", hipGetErrorString(e), grid);
#endif
}
```
